# Optimizing an MI355X kernel written in HIP

```python
import math, functools
import jax, jax.numpy as jnp
from jax import lax
import numpy as np

D_MODEL = 1024
BATCH = 4
SEQ = 4096
DEPTH = 1
DEC_BATCH = 32
DEC_SEQ = 4
PAST_LEN = 8192
PAGE_SIZE = 128

D_A = D_MODEL // 2
G_A = 4
C_G = D_A // G_A
CHUNK = 128
HEAD_DIM = 64
H_G = 8
GROUPS = ((128, 1), (512, 4), (2048, 16))
N_GROUPS = 3
N_HEADS_B = H_G * N_GROUPS
D_QKV = N_HEADS_B * HEAD_DIM
D_B_OUT = H_G * HEAD_DIM
N_KEYS = 129
SUB_BLOCK = 128
ROT_DIM = HEAD_DIM // 4
ROPE_THETA = 500000.0
D_FF = 4 * D_MODEL
D_PLE = 256
D_IN = 2 * D_A + 3 * D_QKV + 2 * D_MODEL
EPS = 1e-6
NEG = -1e30

kernel_name = "gated_gmlp_dilated_attn_decoder_step"


def _rmsnorm(x, g):
    xf = x.astype(jnp.float32)
    y = xf * lax.rsqrt(jnp.mean(xf * xf, axis=-1, keepdims=True) + EPS) * g.astype(jnp.float32)
    return y.astype(x.dtype)


def _rotary(x, pos):
    half = ROT_DIM // 2
    inv = ROPE_THETA ** (-jnp.arange(half, dtype=jnp.float32) * 2.0 / ROT_DIM)
    ang = pos.astype(jnp.float32)[:, None] * inv[None, :]
    cos = jnp.cos(ang)[:, None, :]
    sin = jnp.sin(ang)[:, None, :]
    x1 = x[..., :half].astype(jnp.float32)
    x2 = x[..., half:ROT_DIM].astype(jnp.float32)
    rot = jnp.concatenate([x1 * cos - x2 * sin, x2 * cos + x1 * sin], axis=-1).astype(x.dtype)
    return jnp.concatenate([rot, x[..., ROT_DIM:]], axis=-1)


def _chunk_mix_prompt(u, v, w_s, b_s):
    B, S, _ = u.shape
    ws = jnp.tril(w_s.astype(jnp.float32))
    vc = v.astype(jnp.float32).reshape(B, S // CHUNK, CHUNK, G_A, C_G)
    mix = jnp.einsum('gts,bcsgd->bctgd', ws, vc) + b_s.astype(jnp.float32).T[None, None, :, :, None]
    return (u.astype(jnp.float32) * mix.reshape(B, S, D_A)).astype(u.dtype)


def _chunk_mix_sample(u, v, w_s, b_s):
    B, T, _ = u.shape
    ws = jnp.tril(w_s.astype(jnp.float32))[:, :T, :T]
    vc = v.astype(jnp.float32).reshape(B, T, G_A, C_G)
    mix = jnp.einsum('gts,bsgd->btgd', ws, vc) + b_s.astype(jnp.float32)[:, :T].T[None, :, :, None]
    return (u.astype(jnp.float32) * mix.reshape(B, T, D_A)).astype(u.dtype)


def _dilated_group_prompt(q, k, v, d):
    B, S, H, Dh = q.shape
    span = SUB_BLOCK * d
    L = -(-S // span) * span
    nb = L // span

    def to_blocks(t):
        t = jnp.pad(t.astype(jnp.float32), ((0, 0), (0, L - S), (0, 0), (0, 0)))
        t = t.reshape(B, L // d, d, H, Dh).transpose(0, 2, 1, 3, 4)
        return t.reshape(B, d, nb, SUB_BLOCK, H, Dh)

    def with_prev(t):
        prev = jnp.pad(t[:, :, :-1], ((0, 0), (0, 0), (1, 0), (0, 0), (0, 0), (0, 0)))
        return jnp.concatenate([prev, t], axis=3)

    qb = to_blocks(q)
    kk = with_prev(to_blocks(k))
    vv = with_prev(to_blocks(v))
    s = jnp.einsum('brnqhd,brnkhd->brnhqk', qb, kk) / math.sqrt(Dh)
    i = jnp.arange(SUB_BLOCK)[:, None]
    j = jnp.arange(2 * SUB_BLOCK)[None, :]
    rel = SUB_BLOCK + i - j
    band = (rel >= 0) & (rel <= N_KEYS - 1)
    exists = (jnp.arange(nb)[:, None, None] > 0) | (j >= SUB_BLOCK)[None]
    mask = (band[None] & exists)[None, None, :, None]
    s = jnp.where(mask, s, NEG)
    m = jnp.max(s, axis=-1, keepdims=True)
    e = jnp.exp(s - m)
    den = jnp.sum(e, axis=-1, keepdims=True)
    o = jnp.einsum('brnhqk,brnkhd->brnhqd', e, vv) / den
    lse = (m + jnp.log(den))[..., 0]
    o = o.transpose(0, 1, 2, 4, 3, 5).reshape(B, d, L // d, H, Dh)
    o = o.transpose(0, 2, 1, 3, 4).reshape(B, L, H, Dh)[:, :S]
    lse = lse.transpose(0, 1, 2, 4, 3).reshape(B, d, L // d, H)
    lse = lse.transpose(0, 2, 1, 3).reshape(B, L, H)[:, :S]
    return o, lse


def _dilated_group_sample(q, k, v, kv_buf, d):
    T = q.shape[1]
    Wb = kv_buf.shape[2]
    kk = jnp.concatenate([kv_buf[:, 0], k.astype(kv_buf.dtype)], axis=1)
    vv = jnp.concatenate([kv_buf[:, 1], v.astype(kv_buf.dtype)], axis=1)
    idx = Wb + jnp.arange(T)[:, None] - jnp.arange(N_KEYS)[None, :] * d
    valid = idx >= 0
    idx = jnp.maximum(idx, 0)
    kg = kk[:, idx].astype(jnp.float32)
    vg = vv[:, idx].astype(jnp.float32)
    s = jnp.einsum('bthd,btjhd->bhtj', q.astype(jnp.float32), kg) / math.sqrt(q.shape[-1])
    s = jnp.where(valid[None, None], s, NEG)
    m = jnp.max(s, axis=-1, keepdims=True)
    e = jnp.exp(s - m)
    den = jnp.sum(e, axis=-1, keepdims=True)
    o = jnp.einsum('bhtj,btjhd->bhtd', e, vg) / den
    lse = (m + jnp.log(den))[..., 0]
    new_buf = jnp.stack([kk[:, -Wb:], vv[:, -Wb:]], axis=1)
    return o.transpose(0, 2, 1, 3), lse.transpose(0, 2, 1), new_buf


def _combine(outs, lses, dtype):
    w = jax.nn.softmax(jnp.stack(lses, axis=0), axis=0)[..., None]
    o = jnp.sum(w * jnp.stack(outs, axis=0), axis=0)
    return o.reshape(*o.shape[:-2], D_B_OUT).astype(dtype)


def _dilated_prompt(q, k, v):
    S = q.shape[1]
    outs, lses, states = [], [], []
    for gi, (win, dil) in enumerate(GROUPS):
        sl = slice(gi * H_G, (gi + 1) * H_G)
        o, lse = _dilated_group_prompt(q[:, :, sl], k[:, :, sl], v[:, :, sl], dil)
        outs.append(o)
        lses.append(lse)
        wb = min(win, S)
        states.append(jnp.stack([k[:, S - wb:, sl], v[:, S - wb:, sl]], axis=1))
    return _combine(outs, lses, q.dtype), states


def _dilated_sample(q, k, v, bufs):
    outs, lses, states = [], [], []
    for gi, (win, dil) in enumerate(GROUPS):
        sl = slice(gi * H_G, (gi + 1) * H_G)
        o, lse, nb = _dilated_group_sample(q[:, :, sl], k[:, :, sl], v[:, :, sl], bufs[gi], dil)
        outs.append(o)
        lses.append(lse)
        states.append(nb)
    return _combine(outs, lses, q.dtype), states


def _layer(x, pe, pos, g_mix, w_in, g_v, w_s, b_s, g_q, g_k, w_oa, w_ob, w_o,
           g_ffn, w_ff1, w_ff2, g_ple, w_ple_gate, w_ple_proj, mix_a, mix_b):
    lead = x.shape[:-1]
    h = _rmsnorm(x, g_mix)
    z = h @ w_in
    cuts = [D_A, 2 * D_A, 2 * D_A + D_QKV, 2 * D_A + 2 * D_QKV, 2 * D_A + 3 * D_QKV,
            2 * D_A + 3 * D_QKV + D_MODEL]
    u, va, q, k, v, gate_a, gate_b = jnp.split(z, cuts, axis=-1)
    u = jax.nn.gelu(u)
    va = _rmsnorm(jax.nn.gelu(va), g_v)
    a = mix_a(u, va, w_s, b_s)
    q = _rotary(_rmsnorm(q.reshape(*lead, N_HEADS_B, HEAD_DIM), g_q), pos)
    k = _rotary(_rmsnorm(k.reshape(*lead, N_HEADS_B, HEAD_DIM), g_k), pos)
    v = v.reshape(*lead, N_HEADS_B, HEAD_DIM)
    b, kv_states = mix_b(q, k, v)
    merged = jax.nn.sigmoid(gate_a) * (a @ w_oa) + jax.nn.sigmoid(gate_b) * (b @ w_ob)
    x = x + merged @ w_o
    h2 = _rmsnorm(x, g_ffn)
    x = x + jnp.square(jax.nn.relu(h2 @ w_ff1)) @ w_ff2
    gate = jax.nn.sigmoid(_rmsnorm(x, g_ple) @ w_ple_gate)
    x = x + gate * (pe @ w_ple_proj)
    return x, kv_states, va


def setup_inputs(seed: int = 0) -> dict:
    key = jax.random.key(seed)
    ks = jax.random.split(key, 32)
    f32 = jnp.float32

    def nrm(k, shape, scale=1.0):
        return jax.random.normal(k, shape, f32) * scale

    def gain(k, shape):
        return 1.0 + 0.05 * jax.random.normal(k, shape, f32)

    out = {
        "x_prompt": nrm(ks[0], (BATCH, SEQ, D_MODEL)),
        "x_sample": nrm(ks[1], (DEC_BATCH, DEC_SEQ, D_MODEL)),
        "p_prompt": nrm(ks[2], (DEPTH, BATCH, SEQ, D_PLE)),
        "p_sample": nrm(ks[3], (DEPTH, DEC_BATCH, DEC_SEQ, D_PLE)),
        "cache_kv_w128": nrm(ks[4], (DEPTH, DEC_BATCH, 2, min(GROUPS[0][0], PAST_LEN), H_G, HEAD_DIM)),
        "cache_kv_w512": nrm(ks[5], (DEPTH, DEC_BATCH, 2, min(GROUPS[1][0], PAST_LEN), H_G, HEAD_DIM)),
        "cache_kv_w2048": nrm(ks[6], (DEPTH, DEC_BATCH, 2, min(GROUPS[2][0], PAST_LEN), H_G, HEAD_DIM)),
        "g_mix": gain(ks[7], (DEPTH, D_MODEL)),
        "w_in": nrm(ks[8], (DEPTH, D_MODEL, D_IN), D_MODEL ** -0.5),
        "g_v": gain(ks[9], (DEPTH, D_A)),
        "w_s": nrm(ks[10], (DEPTH, G_A, CHUNK, CHUNK), CHUNK ** -0.5),
        "b_s": 1.0 + 0.1 * nrm(ks[11], (DEPTH, G_A, CHUNK)),
        "g_q": gain(ks[12], (DEPTH, HEAD_DIM)),
        "g_k": gain(ks[13], (DEPTH, HEAD_DIM)),
        "w_oa": nrm(ks[14], (DEPTH, D_A, D_MODEL), D_A ** -0.5),
        "w_ob": nrm(ks[15], (DEPTH, D_B_OUT, D_MODEL), D_B_OUT ** -0.5),
        "w_o": nrm(ks[16], (DEPTH, D_MODEL, D_MODEL), D_MODEL ** -0.5),
        "g_ffn": gain(ks[17], (DEPTH, D_MODEL)),
        "w_ff1": nrm(ks[18], (DEPTH, D_MODEL, D_FF), D_MODEL ** -0.5),
        "w_ff2": nrm(ks[19], (DEPTH, D_FF, D_MODEL), D_FF ** -0.5),
        "g_ple": gain(ks[20], (DEPTH, D_MODEL)),
        "w_ple_gate": nrm(ks[21], (DEPTH, D_MODEL, D_MODEL), D_MODEL ** -0.5),
        "w_ple_proj": nrm(ks[22], (DEPTH, D_PLE, D_MODEL), D_PLE ** -0.5),
    }
    return out


def reference(x_prompt, x_sample, p_prompt, p_sample, cache_kv_w128, cache_kv_w512, cache_kv_w2048,
              g_mix, w_in, g_v, w_s, b_s, g_q, g_k, w_oa, w_ob, w_o,
              g_ffn, w_ff1, w_ff2, g_ple, w_ple_gate, w_ple_proj):
    S = x_prompt.shape[1]
    T = x_sample.shape[1]
    pos_p = jnp.arange(S, dtype=jnp.int32)
    pos_s = PAST_LEN + jnp.arange(T, dtype=jnp.int32)
    xp, xs = x_prompt, x_sample
    kvp = ([], [], [])
    kvs = ([], [], [])
    cvp, cvs = [], []
    for l in range(DEPTH):
        lw = (g_mix[l], w_in[l], g_v[l], w_s[l], b_s[l], g_q[l], g_k[l], w_oa[l], w_ob[l], w_o[l],
              g_ffn[l], w_ff1[l], w_ff2[l], g_ple[l], w_ple_gate[l], w_ple_proj[l])
        xp, st_p, va_p = _layer(xp, p_prompt[l], pos_p, *lw,
                                mix_a=_chunk_mix_prompt, mix_b=_dilated_prompt)
        bufs = (cache_kv_w128[l], cache_kv_w512[l], cache_kv_w2048[l])
        xs, st_s, va_s = _layer(xs, p_sample[l], pos_s, *lw,
                                mix_a=_chunk_mix_sample,
                                mix_b=functools.partial(_dilated_sample, bufs=bufs))
        for gi in range(N_GROUPS):
            kvp[gi].append(st_p[gi])
            kvs[gi].append(st_s[gi])
        cvp.append(va_p[:, S - CHUNK:])
        cvs.append(va_s)
    kv128_prompt = jnp.stack(kvp[0], axis=0)
    kv512_prompt = jnp.stack(kvp[1], axis=0)
    kv2048_prompt = jnp.stack(kvp[2], axis=0)
    kv128_sample = jnp.stack(kvs[0], axis=0)
    kv512_sample = jnp.stack(kvs[1], axis=0)
    kv2048_sample = jnp.stack(kvs[2], axis=0)
    chunk_v_prompt = jnp.stack(cvp, axis=0)
    chunk_v_sample = jnp.stack(cvs, axis=0)
    return (xp, xs, kv128_prompt, kv512_prompt, kv2048_prompt,
            kv128_sample, kv512_sample, kv2048_sample, chunk_v_prompt, chunk_v_sample)
```

```cpp
#include <hip/hip_runtime.h>
#include <cstdio>
#include <cstdint>
#include <cmath>
constexpr int NWAVES = 8;
constexpr int D = 1024, SEQ = 4096, NBATCH = 4, M_PROMPT = NBATCH * SEQ;
constexpr int DEC_B = 32, DEC_T = 4, M_SAMPLE = DEC_B * DEC_T;
constexpr int MV = M_PROMPT + M_SAMPLE;
constexpr int MP = 16640;
constexpr int PAST_LEN = 8192;
constexpr int D_A = 512, NHB = 24, HD = 64, DQKV = NHB * HD, D_IN = 2 * D_A + 3 * DQKV + 2 * D, D_FF = 4096, D_PLE = 256;
constexpr int C_U = 0, C_VA = 512, C_Q = 1024, C_K = 2560, C_V = 4096, C_GA = 5632, C_GB = 6656;
constexpr float EPS = 1e-6f;
static_assert(D_IN == 7680, "D_IN");

constexpr size_t O_YP = 0, O_YS = 16777216, O_KV128P = O_YS + 131072, O_KV512P = O_KV128P + 524288, O_KV2048P = O_KV512P + 2097152,
                 O_KV128S = O_KV2048P + 8388608, O_KV512S = O_KV128S + 4194304, O_KV2048S = O_KV512S + 16777216,
                 O_CVP = O_KV2048S + 67108864, O_CVS = O_CVP + 262144, O_END = O_CVS + 65536;
static_assert(O_END == 116326400, "out size");

constexpr size_t MiB = 1u << 20;
constexpr size_t WS_CTL = 0, CTL_ZERO_BYTES = 65536;
constexpr size_t WS_WIN = 2 * MiB, WS_WOA = 17 * MiB, WS_WOB = 18 * MiB, WS_WO = 19 * MiB, WS_WFF1 = 21 * MiB, WS_WFF2 = 29 * MiB, WS_WPG = 37 * MiB, WS_WPP = 39 * MiB;
constexpr size_t WS_H = 40 * MiB, WS_PE = 73 * MiB, WS_U = 82 * MiB, WS_VA = 99 * MiB, WS_Q = 116 * MiB, WS_K = 165 * MiB, WS_V = 214 * MiB;
constexpr size_t WS_F = WS_Q;
constexpr size_t WS_GA = 263 * MiB, WS_GB = 296 * MiB, WS_A = 329 * MiB, WS_B = 346 * MiB, WS_MG = 363 * MiB;
constexpr size_t WS_BIG = 396 * MiB;
constexpr size_t WS_T1 = WS_BIG + 70 * MiB, WS_T2 = WS_BIG + 135 * MiB, WS_PJ = WS_BIG + 200 * MiB, WS_FF = WS_BIG + 265 * MiB;
constexpr size_t WS_END = WS_BIG + 488 * MiB;
constexpr size_t WS_OG = WS_END;
constexpr size_t WS_LSE = WS_OG + 48 * MiB;
constexpr size_t WS_SSV = WS_LSE + 2 * MiB;
constexpr size_t WS_WSB = WS_SSV + 1 * MiB;
constexpr size_t WS_SSQ1 = WS_WSB + 1 * MiB, WS_SSQ2 = WS_SSQ1 + 2 * MiB;
constexpr size_t WS_ROT = WS_SSQ2 + 2 * MiB;
constexpr size_t WS_MGS = WS_ROT + 1 * MiB, WS_X1S = WS_MGS + 1 * MiB, WS_X2S = WS_X1S + 1 * MiB;
constexpr size_t WS_END2 = WS_X2S + 1 * MiB;
constexpr size_t WS_T1B = WS_BIG, WS_PJB = WS_BIG + 33 * MiB;
constexpr size_t WS_XB1 = WS_H, WS_XB2 = WS_MG;
static_assert((size_t)MP * 1024 * 2 <= 33 * MiB && (size_t)MP * 256 * 2 <= 9 * MiB && (size_t)MP * 512 * 2 <= 17 * MiB && (size_t)MP * 1536 * 2 <= 49 * MiB, "ws map 1");
static_assert((size_t)MP * 4096 * 2 <= 147 * MiB && (size_t)MP * 1024 * 4 <= 65 * MiB && (size_t)MP * 4096 * 4 <= 260 * MiB && (size_t)MP * 7680 * 4 <= 488 * MiB, "ws map 2");


constexpr int CW_BAR = 4096;

constexpr int RING_OFF = 0, RING_BYTES = 131072;
constexpr int LDSCTL_OFF = RING_BYTES, MISC_OFF = LDSCTL_OFF + 320;
constexpr int ROTT_OFF = LDSCTL_OFF + 1024, LDS_BYTES = ROTT_OFF + 16384 + 1024;


namespace pg8 {
#define PG8_LAS __attribute__((address_space(3)))
typedef unsigned short bf16_t;
typedef short bf16x8 __attribute__((ext_vector_type(8)));
typedef float f32x4 __attribute__((ext_vector_type(4)));
typedef unsigned u32x4 __attribute__((ext_vector_type(4)));
constexpr int BM = 256, BK = 64, HALF = 128, HTB = HALF * BK * 2  , STAGE_BYTES = 8 * HTB, NXCD = 8, WGM = 8;

__host__ __device__ __forceinline__ int lds_byte(int r, int c) { const int st = (r >> 4) * 2 + (c >> 5), rr = r & 15, cc = c & 31, ob = rr * 64 + cc * 2; return st * 1024 + (ob ^ (((ob >> 9) & 1) << 5)); }
__host__ __device__ __forceinline__ void stage_rc(int b, int& R, int& C) { const int st = b / 1024, sb = b % 1024, swz = sb ^ (((sb >> 9) & 1) << 5); R = (st >> 1) * 16 + swz / 64; C = (st & 1) * 32 + (swz % 64) / 2; }
__host__ __device__ __forceinline__ int perm32(int rho) { const int n = rho >> 4, i = rho & 15; return 8 * (i >> 2) + 4 * n + (i & 3); }

struct Unit { int pm, pn, L; };
struct Gemm { const bf16_t* A; const bf16_t* Bt; int M, N, K; };

struct StaticOrder {
    int nM, nN, nwg, G, c;
    __host__ __device__ void init(int M, int N, int G_, int c_) { nM = M / BM; nN = N / BM; nwg = nM * nN; G = G_; c = c_; }
    __host__ __device__ bool next(int i, Unit& u) const {
        const long L = (long)i * G + c; if (L >= nwg) return false; u.L = (int)L;
        int wgid = (int)L; { const int q = nwg / NXCD, r = nwg % NXCD, xcd = wgid % NXCD, off = wgid / NXCD; wgid = (xcd < r ? xcd * (q + 1) : r * (q + 1) + (xcd - r) * q) + off; }
        const int nig = WGM * nN, gid = wgid / nig, fm = gid * WGM, gsz = (nM - fm) < WGM ? (nM - fm) : WGM;
        u.pm = fm + ((wgid % nig) % gsz); u.pn = (wgid % nig) / gsz; return true;
    }
    __device__ __forceinline__ void a_ready(const Unit&) const {}
    __device__ __forceinline__ void done(const Unit&) const {}
};

__device__ __forceinline__ unsigned cvt_pk_bf16(float lo, float hi) { unsigned r; asm volatile("v_cvt_pk_bf16_f32 %0, %1, %2" : "=v"(r) : "v"(lo), "v"(hi)); return r; }
typedef float f32x2 __attribute__((ext_vector_type(2)));
struct EpiF32 {
    static constexpr bool PERM = false, AFTER_DRAIN = false, HEADMAP = false;
    float* C; int ldc; const float* bias;
    __device__ __forceinline__ void operator()(const f32x4 (&acc)[2][2][4][2], const Unit& u, int wr, int wc, int fr, int fq) const {
        const int row0 = u.pm * BM + wr * 64 + fr, col0 = u.pn * BM + wc * 32 + 4 * fq;
        f32x4 bv[2][2];
#pragma unroll
        for (int bj = 0; bj < 2; ++bj)
#pragma unroll
            for (int n = 0; n < 2; ++n) bv[bj][n] = bias ? *(const f32x4*)(bias + col0 + bj * HALF + n * 16) : (f32x4){0.f, 0.f, 0.f, 0.f};
#pragma unroll
        for (int ai = 0; ai < 2; ++ai)
#pragma unroll
            for (int m = 0; m < 4; ++m) { float* rowp = C + (size_t)(row0 + ai * HALF + m * 16) * ldc + col0;
#pragma unroll
                for (int bj = 0; bj < 2; ++bj)
#pragma unroll
                    for (int n = 0; n < 2; ++n) *(f32x4*)(rowp + bj * HALF + n * 16) = acc[ai][bj][m][n] + bv[bj][n]; }
    }
};
struct HalfOrder {
    int c2;
    __device__ __forceinline__ bool next(int i, Unit& u) const { if (c2 < 0 || i >= 2) return false; const int L = i * 128 + c2; u.pm = L >> 2; u.pn = L & 3; u.L = L; return true; }
    __device__ __forceinline__ void a_ready(const Unit&) const {}
    __device__ __forceinline__ void done(const Unit&) const {}
};
__device__ __forceinline__ float ep_sum_xor16(float x) { const unsigned xi = __builtin_bit_cast(unsigned, x); const auto r = __builtin_amdgcn_permlane16_swap(xi, xi, false, false); return __builtin_bit_cast(float, (unsigned)r[0]) + __builtin_bit_cast(float, (unsigned)r[1]); }
__device__ __forceinline__ float ep_sum_xor32(float x) { const unsigned xi = __builtin_bit_cast(unsigned, x); const auto r = __builtin_amdgcn_permlane32_swap(xi, xi, false, false); return __builtin_bit_cast(float, (unsigned)r[0]) + __builtin_bit_cast(float, (unsigned)r[1]); }
__device__ __forceinline__ float ep_get_xor16(float x, bool odd_row) { const unsigned xi = __builtin_bit_cast(unsigned, x); const auto r = __builtin_amdgcn_permlane16_swap(xi, xi, false, false); return __builtin_bit_cast(float, odd_row ? (unsigned)r[0] : (unsigned)r[1]); }
__device__ __forceinline__ float ep_sigmoid(float x) { return __builtin_amdgcn_rcpf(1.0f + __builtin_amdgcn_exp2f(-1.4426950408889634f * x)); }
__device__ __forceinline__ float ep_gelu(float x) { const float y = 0.7978845608028654f * (x + 0.044715f * x * x * x); return x * ep_sigmoid(2.0f * y); }
typedef __bf16 ep_bf16x2 __attribute__((ext_vector_type(2)));
__device__ __forceinline__ unsigned ep_cvt2(float lo, float hi) { f32x2 v = {lo, hi}; ep_bf16x2 b = __builtin_convertvector(v, ep_bf16x2); return __builtin_bit_cast(unsigned, b); }
__device__ __forceinline__ u32x4 ep_pack8(const float (&v)[8]) { u32x4 w; w.x = ep_cvt2(v[0], v[1]); w.y = ep_cvt2(v[2], v[3]); w.z = ep_cvt2(v[4], v[5]); w.w = ep_cvt2(v[6], v[7]); return w; }
__device__ __forceinline__ float ep_bflo(unsigned w) { return __builtin_bit_cast(float, w << 16); }
__device__ __forceinline__ float ep_bfhi(unsigned w) { return __builtin_bit_cast(float, w & 0xffff0000u); }
__device__ __forceinline__ void ep_unpack8(const u32x4 w, float (&v)[8]) { v[0] = ep_bflo(w.x); v[1] = ep_bfhi(w.x); v[2] = ep_bflo(w.y); v[3] = ep_bfhi(w.y); v[4] = ep_bflo(w.z); v[5] = ep_bfhi(w.z); v[6] = ep_bflo(w.w); v[7] = ep_bfhi(w.w); }
#define EP_X8(x, a_, b_) float x[8] = {a_[0], a_[1], a_[2], a_[3], b_[0], b_[1], b_[2], b_[3]}

constexpr int EP_MPROMPT = 16384, EP_MV = 16512, EP_SEQ = 4096, EP_DECT = 4;
__device__ __forceinline__ int ep_perm_row(int m, int g) {
    if (g == 0 || m >= EP_MPROMPT) return m;
    const int b = m >> 12, t = m & 4095, sh = (g == 1) ? 2 : 4;
    return (b << 12) + (t & ((1 << sh) - 1)) * (4096 >> sh) + (t >> sh);
}

struct EpiIn {
    static constexpr bool PERM = true, AFTER_DRAIN = false, HEADMAP = true;
    unsigned char* ws; float* out; const float* g_q; const float* g_k; PG8_LAS float* rott;
    __device__ __forceinline__ void state_out(const float (&y0)[8], const float (&y1)[8], int row, int g, int hh, int c, int fq) const {
        const int W = 128 << (2 * g);
        const size_t okp = (g == 0) ? O_KV128P : (g == 1) ? O_KV512P : O_KV2048P, oks = (g == 0) ? O_KV128S : (g == 1) ? O_KV512S : O_KV2048S;
        float* o = nullptr;
        if (row < EP_MPROMPT) { const int b = row >> 12, t = row & 4095; if (t >= EP_SEQ - W) o = out + okp + ((((size_t)b * 2 + c) * W + (t - (EP_SEQ - W))) * 8 + hh) * 64; }
        else if (row < EP_MV) { const int b = (row - EP_MPROMPT) >> 2, t = (row - EP_MPROMPT) & 3; o = out + oks + ((((size_t)b * 2 + c) * W + (W - EP_DECT + t)) * 8 + hh) * 64; }
        if (o) { o += 8 * fq; __builtin_nontemporal_store((f32x4){y0[0], y0[1], y0[2], y0[3]}, (f32x4*)o); __builtin_nontemporal_store((f32x4){y0[4], y0[5], y0[6], y0[7]}, (f32x4*)(o + 4));
                 __builtin_nontemporal_store((f32x4){y1[0], y1[1], y1[2], y1[3]}, (f32x4*)(o + 32)); __builtin_nontemporal_store((f32x4){y1[4], y1[5], y1[6], y1[7]}, (f32x4*)(o + 36)); }
    }
    __device__ __forceinline__ void operator()(const f32x4 (&acc)[2][2][4][2], const Unit& u, int wr, int wc, int fr, int fq) const {
        const int pn = u.pn, row0 = u.pm * BM + wr * 64 + fr, cw = 64 * wc + 8 * fq;
        bf16_t* const U = (bf16_t*)(ws + WS_U); bf16_t* const VA = (bf16_t*)(ws + WS_VA); bf16_t* const V = (bf16_t*)(ws + WS_V); float* const SSV = (float*)(ws + WS_SSV); const float* const ROT = (const float*)(ws + WS_ROT);
        if (pn < 2) {
#pragma unroll
            for (int ai = 0; ai < 2; ++ai)
#pragma unroll
                for (int m = 0; m < 4; ++m) { const int row = row0 + ai * HALF + m * 16;
#pragma unroll
                    for (int bj = 0; bj < 2; ++bj) { EP_X8(x, acc[ai][bj][m][0], acc[ai][bj][m][1]);
#pragma unroll
                        for (int e = 0; e < 8; ++e) x[e] = ep_gelu(x[e]);
                        *(u32x4*)(U + (size_t)row * 512 + 256 * pn + cw + 32 * bj) = ep_pack8(x); } }
        } else if (pn < 4) {
#pragma unroll
            for (int ai = 0; ai < 2; ++ai)
#pragma unroll
                for (int m = 0; m < 4; ++m) { const int row = row0 + ai * HALF + m * 16; float ss = 0.f;
#pragma unroll
                    for (int bj = 0; bj < 2; ++bj) { EP_X8(x, acc[ai][bj][m][0], acc[ai][bj][m][1]);
#pragma unroll
                        for (int e = 0; e < 8; ++e) { x[e] = ep_gelu(x[e]); ss += x[e] * x[e]; }
                        *(u32x4*)(VA + (size_t)row * 512 + 256 * (pn - 2) + cw + 32 * bj) = ep_pack8(x); }
                    ss = ep_sum_xor32(ep_sum_xor16(ss));
                    if (fq == 0) SSV[(size_t)row * 8 + (pn - 2) * 4 + wc] = ss; }
        } else if (pn < 16) {
            const bool isk = pn >= 10; const int hd = 4 * (pn - (isk ? 10 : 4)) + wc, g = hd >> 3, hh = hd & 7;
            const float* gq_ = g_q; const float* gk_ = g_k; asm volatile("" : "+s"(gq_), "+s"(gk_));
            const float* gp = (isk ? gk_ : gq_) + 8 * fq;
            const f32x4 ga0 = *(const f32x4*)gp, ga1 = *(const f32x4*)(gp + 4), gb0 = *(const f32x4*)(gp + 32), gb1 = *(const f32x4*)(gp + 36);
            const float gn0[8] = {ga0[0], ga0[1], ga0[2], ga0[3], ga1[0], ga1[1], ga1[2], ga1[3]}, gn1[8] = {gb0[0], gb0[1], gb0[2], gb0[3], gb1[0], gb1[1], gb1[2], gb1[3]};
            bf16_t* dst = (bf16_t*)(ws + (isk ? WS_K : WS_Q));
            { const int t = (wr * 4 + wc) * 64 + fq * 16 + fr, lr = t >> 1, hf = t & 1;
              const float* rt = ROT + (size_t)((u.pm * BM + lr) & 4095) * 16 + hf * 8;
              const f32x4 a0 = *(const f32x4*)rt, a1 = *(const f32x4*)(rt + 4);
              *(PG8_LAS f32x4*)(rott + lr * 16 + hf * 8) = a0; *(PG8_LAS f32x4*)(rott + lr * 16 + hf * 8 + 4) = a1;
              asm volatile("s_waitcnt lgkmcnt(0)" ::: "memory"); __builtin_amdgcn_s_barrier(); }
#pragma unroll
            for (int ai = 0; ai < 2; ++ai)
#pragma unroll
                for (int m = 0; m < 4; ++m) { const int row = row0 + ai * HALF + m * 16;
                    EP_X8(y0, acc[ai][0][m][0], acc[ai][0][m][1]); EP_X8(y1, acc[ai][1][m][0], acc[ai][1][m][1]);
                    float ss = 0.f;
#pragma unroll
                    for (int e = 0; e < 8; ++e) ss += y0[e] * y0[e] + y1[e] * y1[e];
                    ss = ep_sum_xor32(ep_sum_xor16(ss));
                    const float r = __builtin_amdgcn_rsqf(ss * (1.f / 64.f) + 1e-6f);
#pragma unroll
                    for (int e = 0; e < 8; ++e) { y0[e] *= r * gn0[e]; y1[e] *= r * gn1[e]; }
                    const PG8_LAS float* rt = rott + (wr * 64 + fr + ai * HALF + m * 16) * 16;
                    const f32x4 t0 = *(const PG8_LAS f32x4*)rt, t1 = *(const PG8_LAS f32x4*)(rt + 4), t2 = *(const PG8_LAS f32x4*)(rt + 8), t3 = *(const PG8_LAS f32x4*)(rt + 12);
                    const float cs[8] = {t0[0], t0[2], t1[0], t1[2], t2[0], t2[2], t3[0], t3[2]}, sn[8] = {t0[1], t0[3], t1[1], t1[3], t2[1], t2[3], t3[1], t3[3]};
#pragma unroll
                    for (int e = 0; e < 8; ++e) { const float pr = ep_get_xor16(y0[e], (fq & 1) != 0);
                        if (fq == 0) y0[e] = y0[e] * cs[e] - pr * sn[e]; else if (fq == 1) y0[e] = y0[e] * cs[e] + pr * sn[e]; }
                    bf16_t* d = dst + (size_t)ep_perm_row(row, g) * 1536 + hd * 64 + 8 * fq;
                    *(u32x4*)d = ep_pack8(y0); *(u32x4*)(d + 32) = ep_pack8(y1);
                    if (isk) state_out(y0, y1, row, g, hh, 0, fq);
                    asm volatile("" ::: "memory");
                }
        } else if (pn < 22) {
            const int hd = 4 * (pn - 16) + wc, g = hd >> 3, hh = hd & 7;
#pragma unroll
            for (int ai = 0; ai < 2; ++ai)
#pragma unroll
                for (int m = 0; m < 4; ++m) { const int row = row0 + ai * HALF + m * 16;
                    EP_X8(y0, acc[ai][0][m][0], acc[ai][0][m][1]); EP_X8(y1, acc[ai][1][m][0], acc[ai][1][m][1]);
                    bf16_t* d = V + (size_t)ep_perm_row(row, g) * 1536 + hd * 64 + 8 * fq;
                    *(u32x4*)d = ep_pack8(y0); *(u32x4*)(d + 32) = ep_pack8(y1);
                    state_out(y0, y1, row, g, hh, 1, fq);
                    asm volatile("" ::: "memory");
                }
        } else {
            bf16_t* dst = (bf16_t*)(ws + ((pn < 26) ? WS_GA : WS_GB)); const int ct = 256 * ((pn - 22) & 3);
#pragma unroll
            for (int ai = 0; ai < 2; ++ai)
#pragma unroll
                for (int m = 0; m < 4; ++m) { const int row = row0 + ai * HALF + m * 16;
#pragma unroll
                    for (int bj = 0; bj < 2; ++bj) { EP_X8(x, acc[ai][bj][m][0], acc[ai][bj][m][1]);
#pragma unroll
                        for (int e = 0; e < 8; ++e) x[e] = ep_sigmoid(x[e]);
                        *(u32x4*)(dst + (size_t)row * 1024 + ct + cw + 32 * bj) = ep_pack8(x); } }
        }
    }
};

template <int MODE> struct EpiGate {
    static constexpr bool PERM = true, AFTER_DRAIN = false, HEADMAP = false;
    bf16_t* O; const bf16_t* G; const bf16_t* T; int ldc;
    __device__ __forceinline__ void operator()(const f32x4 (&acc)[2][2][4][2], const Unit& u, int wr, int wc, int fr, int fq) const {
        const int row0 = u.pm * BM + wr * 64 + fr, col0 = u.pn * BM + wc * 32 + 8 * fq;
#pragma unroll
        for (int ai = 0; ai < 2; ++ai)
#pragma unroll
            for (int m = 0; m < 4; ++m) { const size_t ro = (size_t)(row0 + ai * HALF + m * 16) * ldc + col0;
#pragma unroll
                for (int bj = 0; bj < 2; ++bj) { EP_X8(x, acc[ai][bj][m][0], acc[ai][bj][m][1]);
                    if (MODE < 2) { float gv[8]; ep_unpack8(*(const u32x4*)(G + ro + bj * HALF), gv);
#pragma unroll
                        for (int e = 0; e < 8; ++e) x[e] *= gv[e]; }
                    if (MODE == 1) { float tv[8]; ep_unpack8(*(const u32x4*)(T + ro + bj * HALF), tv);
#pragma unroll
                        for (int e = 0; e < 8; ++e) x[e] += tv[e]; }
                    *(u32x4*)(O + ro + bj * HALF) = ep_pack8(x); }
                asm volatile("" ::: "memory"); }
    }
};

__device__ __forceinline__ float ep_rstd16(const float* SSQ, int row);
template <bool XIN_BF16> struct EpiResid {
    static constexpr bool PERM = true, AFTER_DRAIN = false, HEADMAP = false;
    const void* xold; bf16_t* XB; float* SSQ; const float* SSQ_IN;
    __device__ __forceinline__ void operator()(const f32x4 (&acc)[2][2][4][2], const Unit& u, int wr, int wc, int fr, int fq) const {
        const int row0 = u.pm * BM + wr * 64 + fr, col0 = u.pn * BM + wc * 32 + 8 * fq;
#pragma unroll
        for (int ai = 0; ai < 2; ++ai)
#pragma unroll
            for (int m = 0; m < 4; ++m) { const int row = row0 + ai * HALF + m * 16; float ss = 0.f; float r2 = 1.f; if (SSQ_IN) { const float r = ep_rstd16(SSQ_IN, row); r2 = r * r; }
#pragma unroll
                for (int bj = 0; bj < 2; ++bj) { EP_X8(x, acc[ai][bj][m][0], acc[ai][bj][m][1]); const size_t o = (size_t)row * 1024 + col0 + bj * HALF;
#pragma unroll
                    for (int e = 0; e < 8; ++e) x[e] *= r2;
                    if (XIN_BF16) { float xo[8]; ep_unpack8(*(const u32x4*)((const bf16_t*)xold + o), xo);
#pragma unroll
                        for (int e = 0; e < 8; ++e) x[e] += xo[e]; }
                    else { const f32x4 a0 = __builtin_nontemporal_load((const f32x4*)((const float*)xold + o)), a1 = __builtin_nontemporal_load((const f32x4*)((const float*)xold + o + 4));
                        x[0] += a0[0]; x[1] += a0[1]; x[2] += a0[2]; x[3] += a0[3]; x[4] += a1[0]; x[5] += a1[1]; x[6] += a1[2]; x[7] += a1[3]; }
#pragma unroll
                    for (int e = 0; e < 8; ++e) ss += x[e] * x[e];
                    *(u32x4*)(XB + o) = ep_pack8(x); }
                ss = ep_sum_xor32(ep_sum_xor16(ss));
                if (fq == 0) SSQ[(size_t)row * 16 + u.pn * 4 + wc] = ss;
                asm volatile("" ::: "memory"); }
    }
};
__device__ __forceinline__ float ep_rstd16(const float* SSQ, int row) {
    const f32x4 s0 = *(const f32x4*)(SSQ + (size_t)row * 16), s1 = *(const f32x4*)(SSQ + (size_t)row * 16 + 4), s2 = *(const f32x4*)(SSQ + (size_t)row * 16 + 8), s3 = *(const f32x4*)(SSQ + (size_t)row * 16 + 12);
    const float ss = (((s0[0] + s0[1]) + (s0[2] + s0[3])) + ((s1[0] + s1[1]) + (s1[2] + s1[3]))) + (((s2[0] + s2[1]) + (s2[2] + s2[3])) + ((s3[0] + s3[1]) + (s3[2] + s3[3])));
    return __builtin_amdgcn_rsqf(ss * (1.f / 1024.f) + 1e-6f);
}
struct EpiFF1 {
    static constexpr bool PERM = true, AFTER_DRAIN = false, HEADMAP = false;
    bf16_t* F; int ldc;
    __device__ __forceinline__ void operator()(const f32x4 (&acc)[2][2][4][2], const Unit& u, int wr, int wc, int fr, int fq) const {
        const int row0 = u.pm * BM + wr * 64 + fr, col0 = u.pn * BM + wc * 32 + 8 * fq;
#pragma unroll
        for (int ai = 0; ai < 2; ++ai)
#pragma unroll
            for (int m = 0; m < 4; ++m) { const int row = row0 + ai * HALF + m * 16;
#pragma unroll
                for (int bj = 0; bj < 2; ++bj) { EP_X8(x, acc[ai][bj][m][0], acc[ai][bj][m][1]);
#pragma unroll
                    for (int e = 0; e < 8; ++e) { const float t = fmaxf(x[e], 0.f); x[e] = t * t; }
                    *(u32x4*)(F + (size_t)row * ldc + col0 + bj * HALF) = ep_pack8(x); }
                asm volatile("" ::: "memory"); }
    }
};
struct EpiFinal {
    static constexpr bool PERM = true, AFTER_DRAIN = false, HEADMAP = false;
    float* y; const bf16_t* X2; const bf16_t* PJ; const float* SSQ;
    __device__ __forceinline__ void operator()(const f32x4 (&acc)[2][2][4][2], const Unit& u, int wr, int wc, int fr, int fq) const {
        const int row0 = u.pm * BM + wr * 64 + fr, col0 = u.pn * BM + wc * 32 + 8 * fq;
#pragma unroll
        for (int ai = 0; ai < 2; ++ai)
#pragma unroll
            for (int m = 0; m < 4; ++m) { const int row = row0 + ai * HALF + m * 16; const float r = ep_rstd16(SSQ, row);
#pragma unroll
                for (int bj = 0; bj < 2; ++bj) { EP_X8(x, acc[ai][bj][m][0], acc[ai][bj][m][1]); const size_t o = (size_t)row * 1024 + col0 + bj * HALF;
                    float pj[8], xo[8]; ep_unpack8(*(const u32x4*)(PJ + o), pj); ep_unpack8(*(const u32x4*)(X2 + o), xo);
#pragma unroll
                    for (int e = 0; e < 8; ++e) x[e] = xo[e] + ep_sigmoid(x[e] * r) * pj[e];
                    __builtin_nontemporal_store((f32x4){x[0], x[1], x[2], x[3]}, (f32x4*)(y + o)); __builtin_nontemporal_store((f32x4){x[4], x[5], x[6], x[7]}, (f32x4*)(y + o + 4)); }
                asm volatile("" ::: "memory"); }
    }
};

constexpr long KVC_TOTAL = 64L * 128 * 1536;
template <int N> struct KvBatch {
    const float* c2; float* out; long lim;
    f32x4 v[N];
    __device__ __forceinline__ bool addr(long i, const f32x4*& s, f32x4*& d) const {
        if (i >= lim) return false;
        const unsigned u = (unsigned)i, seg = u / 196608u, rem = u - seg * 196608u, blk = rem / 1536u, off = rem - blk * 1536u;
        const size_t e = (size_t)seg * (2048 * 128) + (size_t)(16 * blk + 4) * 128 + off;
        s = (const f32x4*)c2 + e; d = (f32x4*)(out + O_KV2048S) + e - 512; return true;
    }
    __device__ __forceinline__ void load(long e0, int tid) {
#pragma unroll
        for (int k = 0; k < N; ++k) { const f32x4* s; f32x4* d; if (addr(e0 + 512 * k + tid, s, d)) v[k] = __builtin_nontemporal_load(s); }
    }
    __device__ __forceinline__ void store(long e0, int tid) {
        asm volatile("" : "+v"(tid));
#pragma unroll
        for (int k = 0; k < N; ++k) { const f32x4* s; f32x4* d; if (addr(e0 + 512 * k + tid, s, d)) __builtin_nontemporal_store(v[k], d); }
    }
};
constexpr int KVC_BN = 14, KVC_GN = 0;
constexpr long KVC_E_GEMM = KVC_TOTAL - 4480L * 512 * KVC_GN;
static_assert(KVC_E_GEMM >= 0 && 8L * 256 * 448 * KVC_BN >= KVC_E_GEMM, "the copy does not fit its hosts");
struct KvCopy {
    KvBatch<KVC_GN> b; int base;
    __device__ __forceinline__ void load(const Unit& u, int tid) { b.load(KVC_E_GEMM + (long)(base + u.L) * (512 * KVC_GN), tid); }
    __device__ __forceinline__ void store(const Unit& u, int tid) { b.store(KVC_E_GEMM + (long)(base + u.L) * (512 * KVC_GN), tid); }
};

struct NoCopy { __device__ __forceinline__ void load(const Unit&, int) {} __device__ __forceinline__ void store(const Unit&, int) {} };
template <class Epi, class Sched, bool ALIGN_EPI = false, bool SP2 = false, class CP = NoCopy>
__device__ __forceinline__ void gemm_phase(PG8_LAS unsigned char* lds, const Gemm g, const Sched& S, const Epi& E, CP cp = CP()) {
    int tid_ = threadIdx.x; asm volatile("" : "+v"(tid_));
    const int tid = tid_, wid = __builtin_amdgcn_readfirstlane(tid >> 6), lane = tid & 63, wr = wid >> 2, wc = wid & 3, fr = lane & 15, fq = lane >> 4;
    const int K = g.K, nt = K / BK;
    unsigned voffA[2], voffB[2];
#pragma unroll
    for (int i = 0; i < 2; ++i) { int R, C; stage_rc(tid * 16 + i * 8192, R, C); const int Rb = Epi::HEADMAP ? (64 * (R >> 5) + perm32(R & 31)) : (Epi::PERM ? ((R & ~31) + perm32(R & 31)) : R);
        voffA[i] = (unsigned)(R * K + C) * 2u; voffB[i] = (unsigned)(Rb * K + C) * 2u; }
    const size_t kstep = (size_t)(BK * 2);
    const size_t hstep = (size_t)HALF * K * 2;
    const size_t tstep = 2 * hstep;
    const size_t hstepB = Epi::HEADMAP ? (size_t)32 * K * 2 : hstep;
    const unsigned ldsw = (unsigned)wid * 1024u;
    const int aoff = lds_byte(wr * 64 + fr, fq * 8), boff = lds_byte(wc * 32 + fr, fq * 8);
#define PG8_SA(b, h) (((b) * 2 + (h)) * HTB)
#define PG8_SB(b, h) ((4 + (b) * 2 + (h)) * HTB)
#define PG8_STAGE(bufoff, gbase, voff) do { _Pragma("unroll") for (int _i = 0; _i < 2; ++_i) \
        __builtin_amdgcn_global_load_lds((const unsigned*)((const char*)(gbase) + (voff)[_i]), (PG8_LAS unsigned*)(lds + (bufoff) + ldsw + _i * 8192), 16, 0, 0); } while (0)
#define PG8_LDA(dst, b, h) do { _Pragma("unroll") for (int m = 0; m < 4; ++m) _Pragma("unroll") for (int k = 0; k < 2; ++k) dst[m][k] = *(const PG8_LAS bf16x8*)(lds + PG8_SA(b, h) + aoff + m * 2048 + k * 1024); } while (0)
#define PG8_LDB(dst, b, h) do { _Pragma("unroll") for (int n = 0; n < 2; ++n) _Pragma("unroll") for (int k = 0; k < 2; ++k) dst[n][k] = *(const PG8_LAS bf16x8*)(lds + PG8_SB(b, h) + boff + n * 2048 + k * 1024); } while (0)
#define PG8_MMA(ai, bj, At, Bt) do { __builtin_amdgcn_s_setprio(1); _Pragma("unroll") for (int m = 0; m < 4; ++m) _Pragma("unroll") for (int n = 0; n < 2; ++n) _Pragma("unroll") for (int k = 0; k < 2; ++k) \
        acc[ai][bj][m][n] = __builtin_amdgcn_mfma_f32_16x16x32_bf16(Bt[n][k], At[m][k], acc[ai][bj][m][n], 0, 0, 0); __builtin_amdgcn_s_setprio(0); } while (0)
#define PG8_WAIT_V(n) asm volatile("s_waitcnt vmcnt(" #n ")" ::: "memory")
#define PG8_WAIT_L(n) asm volatile("s_waitcnt lgkmcnt(" #n ")" ::: "memory")
#define PG8_BAR __builtin_amdgcn_s_barrier()
#define PG8_SCHED __builtin_amdgcn_sched_barrier(0)
    Unit cur, nxt; int ui = 0;
    if (!S.next(0, cur)) return;
    f32x4 acc[2][2][4][2];
#pragma unroll
    for (int a = 0; a < 2; ++a)
#pragma unroll
        for (int b = 0; b < 2; ++b)
#pragma unroll
            for (int m = 0; m < 4; ++m)
#pragma unroll
                for (int n = 0; n < 2; ++n) acc[a][b][m][n] = (f32x4){0.f, 0.f, 0.f, 0.f};
    bf16x8 At[4][2], B0[2][2], B1[2][2];
    const char* cA = (const char*)g.A + (size_t)cur.pm * tstep; const char* cB = (const char*)g.Bt + (size_t)cur.pn * tstep;
    S.a_ready(cur);
    if constexpr (SP2) {
        PG8_STAGE(PG8_SB(0, 0), cB, voffB); PG8_STAGE(PG8_SB(0, 1), cB + hstepB, voffB); PG8_STAGE(PG8_SA(0, 0), cA, voffA); PG8_STAGE(PG8_SA(0, 1), cA + hstep, voffA);
        if (wr == 1) PG8_BAR;
        PG8_WAIT_V(2); PG8_BAR;
        PG8_STAGE(PG8_SB(1, 0), cB + kstep, voffB); PG8_STAGE(PG8_SA(1, 0), cA + kstep, voffA); PG8_STAGE(PG8_SB(1, 1), cB + hstepB + kstep, voffB);
        PG8_WAIT_V(6); PG8_BAR;
    } else {
        PG8_STAGE(PG8_SB(0, 0), cB, voffB); PG8_STAGE(PG8_SA(0, 0), cA, voffA); PG8_STAGE(PG8_SB(0, 1), cB + hstepB, voffB); PG8_STAGE(PG8_SA(0, 1), cA + hstep, voffA);
        if (wr == 1) PG8_BAR;
        PG8_WAIT_V(4); PG8_BAR;
        PG8_STAGE(PG8_SB(1, 0), cB + kstep, voffB); PG8_STAGE(PG8_SA(1, 0), cA + kstep, voffA); PG8_STAGE(PG8_SB(1, 1), cB + hstepB + kstep, voffB);
        PG8_WAIT_V(6); PG8_BAR;
    }
    for (;;) {
        const bool has_next = S.next(ui + 1, nxt);
        const char* nA = has_next ? (const char*)g.A + (size_t)nxt.pm * tstep : cA; const char* nB = has_next ? (const char*)g.Bt + (size_t)nxt.pn * tstep : cB;
#pragma unroll 1
        for (int t = 0; t < nt; t += 2) {
            const bool last = (t == nt - 2);
            const char* a1 = cA + (size_t)(t + 1) * kstep;
            const char* a2 = last ? nA : cA + (size_t)(t + 2) * kstep; const char* b2 = last ? nB : cB + (size_t)(t + 2) * kstep;
            const char* a3 = a2 + kstep; const char* b3 = b2 + kstep;
            if (last && has_next) S.a_ready(nxt);
            if constexpr (SP2) {
            PG8_LDB(B0, 0, 0); PG8_LDB(B1, 0, 1); PG8_SCHED; PG8_LDA(At, 0, 0); PG8_STAGE(PG8_SA(1, 1), a1 + hstep, voffA);
            PG8_WAIT_V(8); PG8_WAIT_L(0); PG8_BAR; PG8_MMA(0, 0, At, B0); PG8_MMA(0, 1, At, B1); PG8_BAR; PG8_SCHED;
            PG8_LDA(At, 0, 1); PG8_STAGE(PG8_SB(0, 0), b2, voffB); PG8_STAGE(PG8_SB(0, 1), b2 + hstepB, voffB); PG8_STAGE(PG8_SA(0, 0), a2, voffA);
            PG8_WAIT_V(8); PG8_WAIT_L(0); PG8_BAR; PG8_MMA(1, 0, At, B0); PG8_MMA(1, 1, At, B1); PG8_BAR; PG8_SCHED;
            PG8_LDB(B0, 1, 0); PG8_LDB(B1, 1, 1); PG8_SCHED; PG8_LDA(At, 1, 0); PG8_STAGE(PG8_SA(0, 1), a2 + hstep, voffA);
            PG8_WAIT_V(8); PG8_WAIT_L(0); PG8_BAR; PG8_MMA(0, 0, At, B0); PG8_MMA(0, 1, At, B1); PG8_BAR; PG8_SCHED;
            PG8_LDA(At, 1, 1); PG8_STAGE(PG8_SB(1, 0), b3, voffB); PG8_STAGE(PG8_SB(1, 1), b3 + hstepB, voffB); PG8_STAGE(PG8_SA(1, 0), a3, voffA);
            PG8_WAIT_V(8); PG8_WAIT_L(0); PG8_BAR; PG8_MMA(1, 0, At, B0); PG8_MMA(1, 1, At, B1); PG8_BAR; PG8_SCHED;
            } else {
            PG8_LDB(B0, 0, 0); PG8_SCHED; PG8_LDA(At, 0, 0); PG8_STAGE(PG8_SA(1, 1), a1 + hstep, voffA);
            PG8_WAIT_L(8); PG8_BAR; PG8_WAIT_L(0); PG8_MMA(0, 0, At, B0); PG8_BAR; PG8_SCHED;
            PG8_LDB(B1, 0, 1); PG8_STAGE(PG8_SB(0, 0), b2, voffB);
            PG8_BAR; PG8_WAIT_L(0); PG8_MMA(0, 1, At, B1); PG8_BAR;
            PG8_LDA(At, 0, 1); PG8_STAGE(PG8_SA(0, 0), a2, voffA);
            PG8_BAR; PG8_WAIT_L(0); PG8_MMA(1, 0, At, B0); PG8_BAR; PG8_SCHED;
            PG8_STAGE(PG8_SB(0, 1), b2 + hstepB, voffB);
            PG8_WAIT_V(6); PG8_BAR; PG8_MMA(1, 1, At, B1); PG8_BAR;
            PG8_LDB(B0, 1, 0); PG8_SCHED; PG8_LDA(At, 1, 0); PG8_STAGE(PG8_SA(0, 1), a2 + hstep, voffA);
            PG8_WAIT_L(8); PG8_BAR; PG8_WAIT_L(0); PG8_MMA(0, 0, At, B0); PG8_BAR; PG8_SCHED;
            PG8_LDB(B1, 1, 1); PG8_STAGE(PG8_SB(1, 0), b3, voffB);
            PG8_BAR; PG8_WAIT_L(0); PG8_MMA(0, 1, At, B1); PG8_BAR;
            PG8_LDA(At, 1, 1); PG8_STAGE(PG8_SA(1, 0), a3, voffA);
            PG8_BAR; PG8_WAIT_L(0); PG8_MMA(1, 0, At, B0); PG8_BAR; PG8_SCHED;
            PG8_STAGE(PG8_SB(1, 1), b3 + hstepB, voffB);
            PG8_WAIT_V(6); PG8_BAR; PG8_MMA(1, 1, At, B1); PG8_BAR;
            }
        }
        if constexpr (ALIGN_EPI) { if (wr == 0) PG8_BAR; }
        if constexpr (!Epi::AFTER_DRAIN) { cp.load(cur, tid); E(acc, cur, wr, wc, fr, fq); cp.store(cur, tid); S.done(cur); }
        if (!has_next) break;
#pragma unroll
        for (int a = 0; a < 2; ++a)
#pragma unroll
            for (int b = 0; b < 2; ++b)
#pragma unroll
                for (int m = 0; m < 4; ++m)
#pragma unroll
                    for (int n = 0; n < 2; ++n) acc[a][b][m][n] = (f32x4){0.f, 0.f, 0.f, 0.f};
        cur = nxt; cA = nA; cB = nB; ++ui;
        if constexpr (ALIGN_EPI) { if (wr == 1) PG8_BAR; }
    }
    PG8_WAIT_V(0);
    if constexpr (!ALIGN_EPI) { if (wr == 0) PG8_BAR; }
    PG8_BAR;
    if constexpr (Epi::AFTER_DRAIN) { E.fused(acc, cur, wr, wc, fr, fq, lds, wid, lane); S.done(cur); }
#undef PG8_SA
#undef PG8_SB
#undef PG8_STAGE
#undef PG8_LDA
#undef PG8_LDB
#undef PG8_MMA
#undef PG8_WAIT_V
#undef PG8_WAIT_L
#undef PG8_BAR
#undef PG8_SCHED
}
}
namespace sg {
typedef short bf16x8 __attribute__((ext_vector_type(8)));
typedef float f32x4 __attribute__((ext_vector_type(4)));
typedef unsigned u32x2 __attribute__((ext_vector_type(2)));
typedef unsigned u32x4 __attribute__((ext_vector_type(4)));
typedef __bf16 bf16x2 __attribute__((ext_vector_type(2)));
typedef float f32x2 __attribute__((ext_vector_type(2)));
__device__ __forceinline__ unsigned cvt2(float lo, float hi) { f32x2 v = {lo, hi}; bf16x2 b = __builtin_convertvector(v, bf16x2); return __builtin_bit_cast(unsigned, b); }
__device__ __forceinline__ float blo(unsigned w) { return __builtin_bit_cast(float, w << 16); }
__device__ __forceinline__ float bhi(unsigned w) { return __builtin_bit_cast(float, w & 0xffff0000u); }
__device__ __forceinline__ float sigm(float x) { return __builtin_amdgcn_rcpf(1.0f + __builtin_amdgcn_exp2f(-1.4426950408889634f * x)); }
__device__ __forceinline__ float gelu(float x) { const float y = 0.7978845608028654f * (x + 0.044715f * x * x * x); return x * sigm(2.0f * y); }

template <int NT, bool AF32, int UN = 4>
__device__ __forceinline__ void core(f32x4 (&acc)[NT], float& ss, const void* A, int lda, int row, const unsigned short* Wt, int ldw, int col0, int k0, int klen, int lane) {
    const int tok = lane & 15, fq = lane >> 4;
    const unsigned short* wp = Wt + (size_t)(col0 + tok) * ldw + k0 + 8 * fq;
    const unsigned short* a16 = (const unsigned short*)A + (size_t)row * lda + k0 + 8 * fq;
    const float* a32 = (const float*)A + (size_t)row * lda + k0 + 8 * fq;
#pragma unroll UN
    for (int k = 0; k < klen; k += 32) {
        bf16x8 af;
        if (AF32) { const f32x4 x0 = *(const f32x4*)(a32 + k), x1 = *(const f32x4*)(a32 + k + 4);
            ss += (x0[0] * x0[0] + x0[1] * x0[1]) + (x0[2] * x0[2] + x0[3] * x0[3]) + (x1[0] * x1[0] + x1[1] * x1[1]) + (x1[2] * x1[2] + x1[3] * x1[3]);
            af = __builtin_bit_cast(bf16x8, (u32x4){cvt2(x0[0], x0[1]), cvt2(x0[2], x0[3]), cvt2(x1[0], x1[1]), cvt2(x1[2], x1[3])}); }
        else af = *(const bf16x8*)(a16 + k);
#pragma unroll
        for (int nt = 0; nt < NT; ++nt) { const bf16x8 bf = *(const bf16x8*)(wp + (size_t)(16 * nt) * ldw + k);
            acc[nt] = __builtin_amdgcn_mfma_f32_16x16x32_bf16(bf, af, acc[nt], 0, 0, 0); }
    }
}
template <bool AF32, int STEPS>
__device__ __forceinline__ void core8(f32x4& out, float& ssout, __attribute__((address_space(3))) float* red, const void* A, int lda, int row0, const unsigned short* Wt, int ldw, int col0, int k0, int lane, int w) {
    const int tok = lane & 15, fq = lane >> 4, kw = k0 + 32 * STEPS * w + 8 * fq;
    bf16x8 af[2][STEPS], bfr[4][STEPS]; float ss[2] = {0.f, 0.f};
    if (AF32) {
        f32x4 x[2][STEPS][2];
#pragma unroll
        for (int rt = 0; rt < 2; ++rt)
#pragma unroll
            for (int s = 0; s < STEPS; ++s) { const float* p = (const float*)A + (size_t)(row0 + 16 * rt + tok) * lda + kw + 32 * s; x[rt][s][0] = *(const f32x4*)p; x[rt][s][1] = *(const f32x4*)(p + 4); }
#pragma unroll
        for (int ct = 0; ct < 4; ++ct)
#pragma unroll
            for (int s = 0; s < STEPS; ++s) bfr[ct][s] = *(const bf16x8*)(Wt + (size_t)(col0 + 16 * ct + tok) * ldw + kw + 32 * s);
#pragma unroll
        for (int rt = 0; rt < 2; ++rt)
#pragma unroll
            for (int s = 0; s < STEPS; ++s) { const f32x4 x0 = x[rt][s][0], x1 = x[rt][s][1];
                ss[rt] += (x0[0] * x0[0] + x0[1] * x0[1]) + (x0[2] * x0[2] + x0[3] * x0[3]) + (x1[0] * x1[0] + x1[1] * x1[1]) + (x1[2] * x1[2] + x1[3] * x1[3]);
                af[rt][s] = __builtin_bit_cast(bf16x8, (u32x4){cvt2(x0[0], x0[1]), cvt2(x0[2], x0[3]), cvt2(x1[0], x1[1]), cvt2(x1[2], x1[3])}); }
    } else {
#pragma unroll
        for (int rt = 0; rt < 2; ++rt)
#pragma unroll
            for (int s = 0; s < STEPS; ++s) af[rt][s] = *(const bf16x8*)((const unsigned short*)A + (size_t)(row0 + 16 * rt + tok) * lda + kw + 32 * s);
#pragma unroll
        for (int ct = 0; ct < 4; ++ct)
#pragma unroll
            for (int s = 0; s < STEPS; ++s) bfr[ct][s] = *(const bf16x8*)(Wt + (size_t)(col0 + 16 * ct + tok) * ldw + kw + 32 * s);
    }
#pragma unroll
    for (int rt = 0; rt < 2; ++rt)
#pragma unroll
        for (int ct = 0; ct < 4; ++ct) { f32x4 acc = (f32x4){0.f, 0.f, 0.f, 0.f};
#pragma unroll
            for (int s = 0; s < STEPS; ++s) acc = __builtin_amdgcn_mfma_f32_16x16x32_bf16(bfr[ct][s], af[rt][s], acc, 0, 0, 0);
            *(__attribute__((address_space(3))) f32x4*)(red + ((w * 8 + rt * 4 + ct) * 64 + lane) * 4) = acc; }
    if (AF32) {
#pragma unroll
        for (int rt = 0; rt < 2; ++rt) { float v = ss[rt]; v += __shfl_xor(v, 16); v += __shfl_xor(v, 32); if (fq == 0) red[16384 + w * 32 + rt * 16 + tok] = v; }
    }
    __syncthreads();
    f32x4 o = (f32x4){0.f, 0.f, 0.f, 0.f}; float so = 0.f;
#pragma unroll
    for (int w2 = 0; w2 < 8; ++w2) { o += *(const __attribute__((address_space(3))) f32x4*)(red + ((w2 * 8 + w) * 64 + lane) * 4); if (AF32) so += red[16384 + w2 * 32 + (w >> 2) * 16 + tok]; }
    out = o; ssout = so;
    __syncthreads();
}
}


#define GAS __attribute__((address_space(1)))
#define LAS __attribute__((address_space(3)))
typedef unsigned short bf16;
typedef unsigned v4u __attribute__((ext_vector_type(4)));
typedef unsigned v2u __attribute__((ext_vector_type(2)));
typedef float f32x4 __attribute__((ext_vector_type(4)));
#define LDS_WAIT() asm volatile("s_waitcnt lgkmcnt(0)" ::: "memory")
#define VM_WAIT() asm volatile("s_waitcnt vmcnt(0)" ::: "memory")
__device__ __forceinline__ unsigned f2bf(float f) { unsigned u = __builtin_bit_cast(unsigned, f); return (u + 0x7fffu + ((u >> 16) & 1u)) >> 16; }
__device__ __forceinline__ unsigned pk2(float lo, float hi) { return f2bf(lo) | (f2bf(hi) << 16); }
__device__ __forceinline__ float bf2f(unsigned short b) { return __builtin_bit_cast(float, (unsigned)b << 16); }
__device__ __forceinline__ float bflo(unsigned w) { return __builtin_bit_cast(float, w << 16); }
__device__ __forceinline__ float bfhi(unsigned w) { return __builtin_bit_cast(float, w & 0xffff0000u); }

#define XB_TMO      128
#define XB_XCNT(j)  (256  + 64 * (j))
#define XB_XSUB(j)  (1280 + 64 * (j))
#define XB_XGEN(j)  (2304 + 64 * (j))
#define XB_TOP      3328
#define XB_TOPGEN   3392
#define XCD_BAR_WORDS 3456
#define XB_SPIN_CAP (1u << 18)

__device__ __forceinline__ unsigned xb_ld(unsigned* p)              { return __hip_atomic_load(p, __ATOMIC_RELAXED, __HIP_MEMORY_SCOPE_AGENT); }
__device__ __forceinline__ unsigned xb_add(unsigned* p, unsigned v) { return __hip_atomic_fetch_add(p, v, __ATOMIC_RELAXED, __HIP_MEMORY_SCOPE_AGENT); }
__device__ __forceinline__ unsigned xb_xcc_id() { return (unsigned)__builtin_amdgcn_s_getreg((3 << 11) | 20) & 0xFu; }
#define XB_SPIN(cond, bar) do { unsigned _sp = 0; while (cond) { __builtin_amdgcn_s_sleep(1); \
    if ((++_sp & 255u) == 0u) { if (xb_ld(&(bar)[XB_TMO])) break; if (_sp > XB_SPIN_CAP) { atomicAdd(&(bar)[XB_TMO], 1u); break; } } } } while (0)

struct XcdBarrier {
    unsigned* bar; unsigned x;
    volatile LAS unsigned* st;
};

__device__ __forceinline__ XcdBarrier xcd_barrier_post(unsigned* bar, volatile LAS unsigned* st) {
    XcdBarrier b; b.bar = bar; b.x = xb_xcc_id(); b.st = st;
    if (threadIdx.x == 0) (void)xb_add(&bar[XB_XCNT(b.x)], 1u);
    return b;
}
__device__ __forceinline__ void xcd_barrier_complete(unsigned* bar, unsigned x, unsigned& nloc, unsigned& nx) {
    const unsigned G = gridDim.x * gridDim.y * gridDim.z;
    unsigned sum, cnt, mine, sp = 0u;
    for (;;) {
        sum = 0u; cnt = 0u; mine = 0u;
#pragma unroll
        for (unsigned j = 0; j < 16; ++j) { const unsigned c = xb_ld(&bar[XB_XCNT(j)]); sum += c; cnt += (c > 0u) ? 1u : 0u; mine = (j == x) ? c : mine; }
        if (sum == G) break;
        __builtin_amdgcn_s_sleep(1);
        if ((++sp & 255u) == 0u) { if (xb_ld(&bar[XB_TMO])) break; if (sp > XB_SPIN_CAP) { atomicAdd(&bar[XB_TMO], 1u); break; } }
    }
    nloc = mine > 0u ? mine : 1u; nx = cnt > 0u ? cnt : 1u;
}

template <int BN> __device__ __forceinline__ void xcd_barrier(const XcdBarrier& b, const float* kvc, float* kvo, long e0) {
    pg8::KvBatch<BN> kb{kvc, kvo, pg8::KVC_E_GEMM, {}}; const long eb = e0 + (long)threadIdx.x - 64;
    asm volatile("s_waitcnt vmcnt(0)" ::: "memory");
    __syncthreads();
    if (threadIdx.x >= 64) {
#pragma unroll
        for (int k = 0; k < BN; ++k) { const f32x4* sp; f32x4* dp; if (kb.addr(eb + 448 * k, sp, dp)) kb.v[k] = __builtin_nontemporal_load(sp); }
#pragma unroll
        for (int k = 0; k < BN; ++k) { const f32x4* sp; f32x4* dp; if (kb.addr(eb + 448 * k, sp, dp)) __builtin_nontemporal_store(kb.v[k], dp); }
    }
    if (threadIdx.x == 0) {
        unsigned* bar = b.bar;
        __builtin_amdgcn_s_waitcnt(0);
        unsigned nloc = b.st[0], nx = b.st[1];
        if (nloc == 0u) { xcd_barrier_complete(bar, b.x, nloc, nx); b.st[0] = nloc; b.st[1] = nx; }
        const unsigned old = xb_add(&bar[XB_XSUB(b.x)], 1u);
        const unsigned gen = old / nloc;
        if (old + 1u == (gen + 1u) * nloc) {
            __builtin_amdgcn_fence(__ATOMIC_RELEASE, "agent");
            asm volatile("s_waitcnt vmcnt(0)" ::: "memory");
            const unsigned og = xb_add(&bar[XB_TOP], 1u);
            const unsigned tg = og / nx;
            if (og + 1u == (tg + 1u) * nx) xb_add(&bar[XB_TOPGEN], 1u);
            else XB_SPIN(xb_ld(&bar[XB_TOPGEN]) == tg, bar);
            __builtin_amdgcn_fence(__ATOMIC_ACQUIRE, "agent");
            xb_add(&bar[XB_XGEN(b.x)], 1u);
            asm volatile("s_waitcnt vmcnt(0)" ::: "memory");
        } else {
            XB_SPIN(xb_ld(&bar[XB_XGEN(b.x)]) == gen, bar);
            __builtin_amdgcn_fence(__ATOMIC_ACQUIRE, "agent");
            asm volatile("s_waitcnt vmcnt(0)" ::: "memory");
        }
    }
    __syncthreads();
}

__device__ __forceinline__ float wave_sum(float v) {
#pragma unroll
    for (int o = 1; o < 64; o <<= 1) v += __shfl_xor(v, o);
    return v;
}
__device__ __forceinline__ float wave_max(float v) {
#pragma unroll
    for (int o = 1; o < 64; o <<= 1) v = fmaxf(v, __shfl_xor(v, o));
    return v;
}
__device__ __forceinline__ float sigmoidf_(float x) { return __builtin_amdgcn_rcpf(1.0f + __builtin_amdgcn_exp2f(-1.4426950408889634f * x)); }
__device__ __forceinline__ float gelu_tanh(float x) { const float y = 0.7978845608028654f * (x + 0.044715f * x * x * x); return x * sigmoidf_(2.0f * y); }

__device__ __forceinline__ void p0_transpose_item(const float* W, int K, int N, bf16* WT, int row_off, LAS float* scr, int item, int lane, const float* gk = nullptr) {
    const int nblk = N / 32, kb = item / nblk, nb = item % nblk, k0 = 64 * kb, n0 = 32 * nb;
    { const int r8 = lane >> 3, c4 = lane & 7;
      f32x4 w[8]; float g[8];
#pragma unroll
      for (int i = 0; i < 8; ++i) { const int kk = 8 * i + r8; w[i] = __builtin_nontemporal_load((const GAS f32x4*)(W + (size_t)(k0 + kk) * N + n0) + c4); g[i] = gk ? gk[k0 + kk] : 1.0f; }
#pragma unroll
      for (int i = 0; i < 8; ++i) { LAS float* d = scr + (8 * i + r8) * 33 + 4 * c4; d[0] = w[i].x * g[i]; d[1] = w[i].y * g[i]; d[2] = w[i].z * g[i]; d[3] = w[i].w * g[i]; } }
    LDS_WAIT(); asm volatile("" ::: "memory");
    const int c = lane & 7;
#pragma unroll
    for (int j = 0; j < 4; ++j) { const int n = (lane >> 3) + 8 * j; const LAS float* s = scr + (8 * c) * 33 + n;
        v4u o; o.x = pk2(s[0 * 33], s[1 * 33]); o.y = pk2(s[2 * 33], s[3 * 33]); o.z = pk2(s[4 * 33], s[5 * 33]); o.w = pk2(s[6 * 33], s[7 * 33]);
        *(GAS v4u*)(WT + (size_t)(row_off + n0 + n) * K + k0 + 8 * c) = o; }
    LDS_WAIT(); asm volatile("" ::: "memory");
}

struct Frame {
    LAS unsigned char* lds;
    int tid, lane, wave, vcu, G;
};

struct Args { const float* in[23]; float* out; unsigned char* ws; };

__device__ __forceinline__ void rot_cs(int pos, int i, float& c, float& s) {
    const float inv = exp2f(-(float)i * (18.931568569324174f / 8.0f));
    const float ang = (float)pos * inv;
    const double rev = (double)ang * 0.15915494309189535;
    const float fr = (float)(rev - floor(rev));
    s = __builtin_amdgcn_sinf(fr); c = __builtin_amdgcn_cosf(fr);
}

__device__ __forceinline__ void p0_prologue(const Frame& F, const Args& a) {
    unsigned char* ws = a.ws;
    LAS float* scr = (LAS float*)(F.lds + RING_OFF + F.wave * 16384);
    const int gw = F.vcu * NWAVES + F.wave, NGW = F.G * NWAVES;
    const int e0 = blockIdx.x * 512 + F.tid;
    float wsv = 0.f; f32x4 xsv = (f32x4){0.f, 0.f, 0.f, 0.f};
    if (e0 < 4 * 128 * 128) wsv = a.in[10][e0];
    if (e0 < M_SAMPLE * D / 4) xsv = ((const GAS f32x4*)a.in[1])[e0];
    {
        float* ROT = (float*)(ws + WS_ROT);
        for (int i = e0; i < 4100 * 8; i += F.G * 512) { const int idx = i >> 3, pos = idx < 4096 ? idx : PAST_LEN + (idx - 4096); float c, sn; rot_cs(pos, i & 7, c, sn); ROT[2 * i] = c; ROT[2 * i + 1] = sn; }
        float* MGS = (float*)(ws + WS_MGS);
        for (int i = e0; i < M_SAMPLE * D / 4; i += F.G * 512) ((GAS f32x4*)MGS)[i] = (f32x4){0.f, 0.f, 0.f, 0.f};
    }
    {
        constexpr int I_IN = (D / 64) * (D_IN / 32), I_OA = (D_A / 64) * (D / 32), I_OB = I_OA, I_O = (D / 64) * (D / 32), I_F1 = (D / 64) * (D_FF / 32), I_F2 = (D_FF / 64) * (D / 32), I_PG = I_O, I_PP = (D_PLE / 64) * (D / 32);
        constexpr int NITEMS = I_IN + I_OA + I_OB + I_O + I_F1 + I_F2 + I_PG + I_PP;
        const float* gm = a.in[7];
        bf16* H = (bf16*)(ws + WS_H); bf16* PE = (bf16*)(ws + WS_PE);
        int it = gw, m0 = gw;
        while (it < NITEMS || m0 < MV) {
            const bool rows = m0 < MV;
            const int m1 = (m0 + NGW < MV) ? m0 + NGW : m0;
            f32x4 v[2][4], p[2];
            if (rows) {
#pragma unroll
                for (int q = 0; q < 2; ++q) { const int m = q ? m1 : m0;
                    const float* xrow = (m < M_PROMPT) ? a.in[0] + (size_t)m * D : a.in[1] + (size_t)(m - M_PROMPT) * D;
                    const float* prow = (m < M_PROMPT) ? a.in[2] + (size_t)m * D_PLE : a.in[3] + (size_t)(m - M_PROMPT) * D_PLE;
#pragma unroll
                    for (int j = 0; j < 4; ++j) v[q][j] = __builtin_nontemporal_load((const GAS f32x4*)xrow + F.lane + 64 * j);
                    p[q] = __builtin_nontemporal_load((const GAS f32x4*)prow + F.lane); }
            }
            if (it < NITEMS) {
                int r = it;
                if (r < I_IN) p0_transpose_item(a.in[8], D, D_IN, (bf16*)(ws + WS_WIN), 0, scr, r, F.lane);
                else if ((r -= I_IN) < I_OA) p0_transpose_item(a.in[14], D_A, D, (bf16*)(ws + WS_WOA), 0, scr, r, F.lane);
                else if ((r -= I_OA) < I_OB) p0_transpose_item(a.in[15], D_A, D, (bf16*)(ws + WS_WOB), 0, scr, r, F.lane);
                else if ((r -= I_OB) < I_O) p0_transpose_item(a.in[16], D, D, (bf16*)(ws + WS_WO), 0, scr, r, F.lane);
                else if ((r -= I_O) < I_F1) p0_transpose_item(a.in[18], D, D_FF, (bf16*)(ws + WS_WFF1), 0, scr, r, F.lane, a.in[17]);
                else if ((r -= I_F1) < I_F2) p0_transpose_item(a.in[19], D_FF, D, (bf16*)(ws + WS_WFF2), 0, scr, r, F.lane);
                else if ((r -= I_F2) < I_PG) p0_transpose_item(a.in[21], D, D, (bf16*)(ws + WS_WPG), 0, scr, r, F.lane, a.in[20]);
                else { r -= I_PG; p0_transpose_item(a.in[22], D_PLE, D, (bf16*)(ws + WS_WPP), 0, scr, r, F.lane); }
                it += NGW;
            }
            if (rows) {
#pragma unroll
                for (int q = 0; q < 2; ++q) { const int m = q ? m1 : m0; float s = 0.f;
#pragma unroll
                    for (int j = 0; j < 4; ++j) s += (v[q][j].x * v[q][j].x + v[q][j].y * v[q][j].y) + (v[q][j].z * v[q][j].z + v[q][j].w * v[q][j].w);
                    const float r = __builtin_amdgcn_rsqf(wave_sum(s) * (1.f / D) + EPS);
                    GAS unsigned long long* o8 = (GAS unsigned long long*)(H + (size_t)m * D) + F.lane;
#pragma unroll
                    for (int j = 0; j < 4; ++j) { const f32x4 g = ((const GAS f32x4*)gm)[F.lane + 64 * j];
                        o8[64 * j] = (unsigned long long)pk2(v[q][j].x * r * g.x, v[q][j].y * r * g.y) | ((unsigned long long)pk2(v[q][j].z * r * g.z, v[q][j].w * r * g.w) << 32); }
                    ((GAS unsigned long long*)(PE + (size_t)m * D_PLE))[F.lane] = (unsigned long long)pk2(p[q].x, p[q].y) | ((unsigned long long)pk2(p[q].z, p[q].w) << 32); }
                m0 += 2 * NGW;
            }
        }
    }
    {
        const float* w_s = a.in[10]; bf16* WSB = (bf16*)(ws + WS_WSB);
        if (e0 < 4 * 128 * 128) { const int t = (e0 >> 7) & 127, sx = e0 & 127; WSB[e0] = (bf16)f2bf(sx <= t ? wsv : 0.f); }
        for (int i = e0 + F.G * 512; i < 4 * 128 * 128; i += F.G * 512) { const int t = (i >> 7) & 127, sx = i & 127; WSB[i] = (bf16)f2bf(sx <= t ? w_s[i] : 0.f); }
        float* X1S = (float*)(ws + WS_X1S); const float* xs = a.in[1];
        if (e0 < M_SAMPLE * D / 4) ((GAS f32x4*)X1S)[e0] = xsv;
        for (int i = e0 + F.G * 512; i < M_SAMPLE * D / 4; i += F.G * 512) ((GAS f32x4*)X1S)[i] = ((const GAS f32x4*)xs)[i];
    }
}

__device__ __forceinline__ int perm_row(int m, int g) {
    if (g == 0 || m >= M_PROMPT) return m;
    const int b = m >> 12, t = m & 4095, sh = (g == 1) ? 2 : 4;
    return (b << 12) + (t & ((1 << sh) - 1)) * (4096 >> sh) + (t >> sh);
}
typedef short bf16x8_t __attribute__((ext_vector_type(8)));
typedef short s16x4_t __attribute__((ext_vector_type(4)));
typedef float f32x16 __attribute__((ext_vector_type(16)));
typedef __bf16 bf16x2v __attribute__((ext_vector_type(2)));
typedef float f32x2v __attribute__((ext_vector_type(2)));
__device__ __forceinline__ unsigned cvtpk(float lo, float hi) { f32x2v v = {lo, hi}; bf16x2v b = __builtin_convertvector(v, bf16x2v); return __builtin_bit_cast(unsigned, b); }
__device__ __forceinline__ int crow(int r, int hi) { return (r & 3) + 8 * (r >> 2) + 4 * hi; }
__device__ __forceinline__ s16x4_t vtr(const LAS unsigned char* p) { return __builtin_bit_cast(s16x4_t, __builtin_amdgcn_ds_read_tr16_b64_v4i16((LAS s16x4_t*)p)); }

constexpr int AT_K = 0, AT_V = 49152, AT_OST = 98304, AT_WSF = 132096;
constexpr float SM_C2 = 0.125f * 1.4426950408889634f;

__device__ __forceinline__ void p3_swa(const Frame& F, const Args& a) {
    unsigned char* ws = a.ws;
    const bf16* Q = (const bf16*)(ws + WS_Q); const bf16* K = (const bf16*)(ws + WS_K); const bf16* V = (const bf16*)(ws + WS_V);
    bf16* OG = (bf16*)(ws + WS_OG); float* LSE = (float*)(ws + WS_LSE);
    const int tid = F.tid, lane = F.lane, w = F.wave, l31 = lane & 31, hi = lane >> 5;
    const LAS unsigned char* ldsK = F.lds + AT_K; const LAS unsigned char* ldsV = F.lds + AT_V;
    LAS float* wsf = (LAS float*)(F.lds + AT_WSF) + w * 64;
    LAS bf16* stg = (LAS bf16*)(F.lds + AT_OST) + w * 2048;
    for (int it = F.vcu; it < 1536; it += F.G) {
        const int g = it >> 9; int rem = it & 511;
        const int j = rem & 7; rem >>= 3; const int b = rem & 3; rem >>= 2;
        const int sh = (g == 0) ? 0 : (g == 1) ? 2 : 4, nqb = 16 >> sh, qb = rem % nqb, r = rem / nqb, Lg = 4096 >> sh;
        const int hh = g * 8 + j;
        const int seqbase = (b << 12) + r * Lg;
        const int k0 = qb * 256 - 128;
        {
            v4u kr[6], vr[6];
#pragma unroll
            for (int k = 0; k < 6; ++k) { const int cidx = tid + 512 * k, row = cidx >> 3, c = cidx & 7; int srow = k0 + row; srow = srow < 0 ? 0 : srow;
                const size_t off = (size_t)(seqbase + srow) * DQKV + hh * HD + c * 8;
                kr[k] = *(const GAS v4u*)(K + off); vr[k] = *(const GAS v4u*)(V + off); }
#pragma unroll
            for (int k = 0; k < 6; ++k) { const int cidx = tid + 512 * k, row = cidx >> 3, c = cidx & 7;
                *(LAS v4u*)(F.lds + AT_K + row * 128 + ((c ^ ((row >> 1) & 7)) << 4)) = kr[k];
                *(LAS v4u*)(F.lds + AT_V + (row >> 3) * 1024 + (c >> 2) * 512 + (row & 7) * 64 + (c & 3) * 16) = vr[k]; }
        }
        bf16x8_t qf[4];
        { const bf16* qp = Q + (size_t)(seqbase + qb * 256 + 32 * w + l31) * DQKV + hh * HD + 8 * hi;
#pragma unroll
          for (int ks = 0; ks < 4; ++ks) qf[ks] = *(const GAS bf16x8_t*)(qp + 16 * ks); }
        __syncthreads();
        f32x16 S[5];
#pragma unroll
        for (int kb = 0; kb < 5; ++kb) {
            S[kb] = (f32x16){0.f,0.f,0.f,0.f,0.f,0.f,0.f,0.f,0.f,0.f,0.f,0.f,0.f,0.f,0.f,0.f};
            const int krow = 32 * (w + kb) + l31;
#pragma unroll
            for (int ks = 0; ks < 4; ++ks) { const int c = 2 * ks + hi;
                const bf16x8_t af = *(const LAS bf16x8_t*)(ldsK + krow * 128 + ((c ^ ((l31 >> 1) & 7)) << 4));
                S[kb] = __builtin_amdgcn_mfma_f32_32x32x16_bf16(af, qf[ks], S[kb], 0, 0, 0); }
        }
        const float NEGB = -1e30f;
#pragma unroll
        for (int rr = 0; rr < 16; ++rr) { const int kl = crow(rr, hi); if (kl < l31) S[0][rr] = NEGB; if (kl > l31) S[4][rr] = NEGB; }
        if (qb == 0) {
#pragma unroll
            for (int kb = 0; kb < 4; ++kb) if (w + kb < 4) {
#pragma unroll
                for (int rr = 0; rr < 16; ++rr) S[kb][rr] = NEGB; }
        }
        float mx = NEGB;
#pragma unroll
        for (int kb = 0; kb < 5; ++kb)
#pragma unroll
            for (int rr = 0; rr < 16; ++rr) mx = fmaxf(mx, S[kb][rr]);
        mx = fmaxf(mx, __shfl_xor(mx, 32));
        const float mc = mx * SM_C2; float lsum = 0.f;
#pragma unroll
        for (int kb = 0; kb < 5; ++kb)
#pragma unroll
            for (int rr = 0; rr < 16; ++rr) { const float p = __builtin_amdgcn_exp2f(S[kb][rr] * SM_C2 - mc); S[kb][rr] = p; lsum += p; }
        lsum += __shfl_xor(lsum, 32);
        f32x16 O[2];
        O[0] = (f32x16){0.f,0.f,0.f,0.f,0.f,0.f,0.f,0.f,0.f,0.f,0.f,0.f,0.f,0.f,0.f,0.f}; O[1] = O[0];
        const int vbase = (4 * hi + ((lane & 15) >> 2)) * 64 + ((lane >> 4) & 1) * 32 + (lane & 3) * 8;
#pragma unroll
        for (int kb = 0; kb < 5; ++kb)
#pragma unroll
            for (int s = 0; s < 2; ++s) {
                v4u pw; pw.x = cvtpk(S[kb][8 * s + 0], S[kb][8 * s + 1]); pw.y = cvtpk(S[kb][8 * s + 2], S[kb][8 * s + 3]); pw.z = cvtpk(S[kb][8 * s + 4], S[kb][8 * s + 5]); pw.w = cvtpk(S[kb][8 * s + 6], S[kb][8 * s + 7]);
                const bf16x8_t pa = __builtin_bit_cast(bf16x8_t, pw);
                const int kg0 = 4 * (w + kb) + 2 * s;
#pragma unroll
                for (int nb = 0; nb < 2; ++nb) {
                    const s16x4_t lo = vtr(ldsV + kg0 * 1024 + nb * 512 + vbase), hv = vtr(ldsV + (kg0 + 1) * 1024 + nb * 512 + vbase);
                    const bf16x8_t vb = (bf16x8_t){lo[0], lo[1], lo[2], lo[3], hv[0], hv[1], hv[2], hv[3]};
                    O[nb] = __builtin_amdgcn_mfma_f32_32x32x16_bf16(pa, vb, O[nb], 0, 0, 0);
                }
            }
        if (hi == 0) wsf[l31] = lsum;
        LDS_WAIT(); asm volatile("" ::: "memory");
#pragma unroll
        for (int rr = 0; rr < 16; ++rr) { const int qr = crow(rr, hi); const float rl = __builtin_amdgcn_rcpf(wsf[qr]);
            stg[qr * 64 + l31] = (bf16)f2bf(O[0][rr] * rl); stg[qr * 64 + 32 + l31] = (bf16)f2bf(O[1][rr] * rl); }
        LDS_WAIT(); asm volatile("" ::: "memory");
        const int mq0 = (b << 12) + r, qi0 = qb * 256 + 32 * w;
#pragma unroll
        for (int i = 0; i < 4; ++i) { const int row = i * 8 + (lane >> 3), ch = lane & 7; const v4u v = *(const LAS v4u*)(stg + row * 64 + ch * 8);
            const int m = mq0 + ((qi0 + row) << sh);
            *(GAS v4u*)(OG + ((size_t)g * M_PROMPT + m) * 512 + j * HD + ch * 8) = v; }
        if (hi == 0) { const int m = mq0 + ((qi0 + l31) << sh); LSE[((size_t)g * M_PROMPT + m) * 8 + j] = mc + __builtin_amdgcn_logf(lsum); }
        __syncthreads();
    }
}

struct SaPass { v4u q0, q1; f32x4 k0, k1, k2, k3, v0, v1, v2, v3; };
__device__ __forceinline__ SaPass sa_load(int idx, const Args& a, const bf16* Q, const bf16* K, const bf16* V, int m, int j, int bs, int tl, int ksub, int part) {
    const int g = idx / 9, ps = idx - 9 * g, d = (g == 0) ? 1 : (g == 1) ? 4 : 16, W = 128 * d, h = g * 8 + j;
    const float* cache = (g == 0) ? a.in[4] : (g == 1) ? a.in[5] : a.in[6];
    SaPass P; const GAS v4u* qp = (const GAS v4u*)(Q + (size_t)m * DQKV + h * HD + 16 * part); P.q0 = qp[0]; P.q1 = qp[1];
    const int i = ps * 16 + ksub; const bool act = i <= 128; const int rel = tl - i * d;
    const f32x4 z4 = (f32x4){0.f, 0.f, 0.f, 0.f};
    P.k0 = z4; P.k1 = z4; P.k2 = z4; P.k3 = z4; P.v0 = z4; P.v1 = z4; P.v2 = z4; P.v3 = z4;
    if (act) {
        if (rel >= 0) { const size_t off = (size_t)(m - i * d) * DQKV + h * HD + 16 * part;
            P.k0 = ((const GAS f32x4*)(K + off))[0]; P.k1 = ((const GAS f32x4*)(K + off))[1]; P.v0 = ((const GAS f32x4*)(V + off))[0]; P.v1 = ((const GAS f32x4*)(V + off))[1]; }
        else { const size_t offk = ((((size_t)bs * 2 + 0) * W + (W + rel)) * 8 + j) * HD + 16 * part, offv = offk + (size_t)W * 8 * HD;
            const GAS f32x4* kp = (const GAS f32x4*)(cache + offk); const GAS f32x4* vp = (const GAS f32x4*)(cache + offv);
            P.k0 = kp[0]; P.k1 = kp[1]; P.k2 = kp[2]; P.k3 = kp[3]; P.v0 = vp[0]; P.v1 = vp[1]; P.v2 = vp[2]; P.v3 = vp[3]; }
    }
    return P;
}
__device__ __forceinline__ void sa_proc(const SaPass P, int idx, const Args& a, int j, int bs, int tl, int ksub, int part, float& mrun, float& sum, float (&o)[16]) {
    const int g = idx / 9, ps = idx - 9 * g, d = (g == 0) ? 1 : (g == 1) ? 4 : 16, W = 128 * d;
    const int i = ps * 16 + ksub; const bool act = i <= 128; const int rel = tl - i * d;
    float q[16], kx[16], vx[16];
    q[0] = bflo(P.q0.x); q[1] = bfhi(P.q0.x); q[2] = bflo(P.q0.y); q[3] = bfhi(P.q0.y); q[4] = bflo(P.q0.z); q[5] = bfhi(P.q0.z); q[6] = bflo(P.q0.w); q[7] = bfhi(P.q0.w);
    q[8] = bflo(P.q1.x); q[9] = bfhi(P.q1.x); q[10] = bflo(P.q1.y); q[11] = bfhi(P.q1.y); q[12] = bflo(P.q1.z); q[13] = bfhi(P.q1.z); q[14] = bflo(P.q1.w); q[15] = bfhi(P.q1.w);
    if (rel >= 0) {
        const v4u k0 = __builtin_bit_cast(v4u, P.k0), k1 = __builtin_bit_cast(v4u, P.k1), v0 = __builtin_bit_cast(v4u, P.v0), v1 = __builtin_bit_cast(v4u, P.v1);
        kx[0] = bflo(k0.x); kx[1] = bfhi(k0.x); kx[2] = bflo(k0.y); kx[3] = bfhi(k0.y); kx[4] = bflo(k0.z); kx[5] = bfhi(k0.z); kx[6] = bflo(k0.w); kx[7] = bfhi(k0.w);
        kx[8] = bflo(k1.x); kx[9] = bfhi(k1.x); kx[10] = bflo(k1.y); kx[11] = bfhi(k1.y); kx[12] = bflo(k1.z); kx[13] = bfhi(k1.z); kx[14] = bflo(k1.w); kx[15] = bfhi(k1.w);
        vx[0] = bflo(v0.x); vx[1] = bfhi(v0.x); vx[2] = bflo(v0.y); vx[3] = bfhi(v0.y); vx[4] = bflo(v0.z); vx[5] = bfhi(v0.z); vx[6] = bflo(v0.w); vx[7] = bfhi(v0.w);
        vx[8] = bflo(v1.x); vx[9] = bfhi(v1.x); vx[10] = bflo(v1.y); vx[11] = bfhi(v1.y); vx[12] = bflo(v1.z); vx[13] = bfhi(v1.z); vx[14] = bflo(v1.w); vx[15] = bfhi(v1.w);
    } else {
        kx[0] = P.k0.x; kx[1] = P.k0.y; kx[2] = P.k0.z; kx[3] = P.k0.w; kx[4] = P.k1.x; kx[5] = P.k1.y; kx[6] = P.k1.z; kx[7] = P.k1.w;
        kx[8] = P.k2.x; kx[9] = P.k2.y; kx[10] = P.k2.z; kx[11] = P.k2.w; kx[12] = P.k3.x; kx[13] = P.k3.y; kx[14] = P.k3.z; kx[15] = P.k3.w;
        vx[0] = P.v0.x; vx[1] = P.v0.y; vx[2] = P.v0.z; vx[3] = P.v0.w; vx[4] = P.v1.x; vx[5] = P.v1.y; vx[6] = P.v1.z; vx[7] = P.v1.w;
        vx[8] = P.v2.x; vx[9] = P.v2.y; vx[10] = P.v2.z; vx[11] = P.v2.w; vx[12] = P.v3.x; vx[13] = P.v3.y; vx[14] = P.v3.z; vx[15] = P.v3.w;
        if (act && (W + rel >= DEC_T) && (g != 0 || tl == 0)) {
            const size_t offk = ((((size_t)bs * 2 + 0) * W + (W + rel - DEC_T)) * 8 + j) * HD + 16 * part, offv = offk + (size_t)W * 8 * HD;
            float* okv = a.out + ((g == 0) ? O_KV128S : (g == 1) ? O_KV512S : O_KV2048S);
            GAS f32x4* ko = (GAS f32x4*)(okv + offk); GAS f32x4* vo = (GAS f32x4*)(okv + offv);
            ko[0] = P.k0; ko[1] = P.k1; ko[2] = P.k2; ko[3] = P.k3; vo[0] = P.v0; vo[1] = P.v1; vo[2] = P.v2; vo[3] = P.v3;
        }
    }
    float s = 0.f;
#pragma unroll
    for (int k = 0; k < 16; ++k) s += q[k] * kx[k];
    s += __shfl_xor(s, 1); s += __shfl_xor(s, 2);
    s *= 0.125f;
    if (act) {
        const float mn = fmaxf(mrun, s), sc = __expf(mrun - mn), p = __expf(s - mn);
        sum = sum * sc + p; mrun = mn;
#pragma unroll
        for (int k = 0; k < 16; ++k) o[k] = o[k] * sc + p * vx[k];
    }
}
__device__ __forceinline__ void p3_sample_attn(const Frame& F, const Args& a) {
    unsigned char* ws = a.ws;
    const bf16* Q = (const bf16*)(ws + WS_Q); const bf16* K = (const bf16*)(ws + WS_K); const bf16* V = (const bf16*)(ws + WS_V);
    bf16* Bb = (bf16*)(ws + WS_B);
    const int lane = F.lane, ksub = lane >> 2, part = lane & 3, half = F.wave & 1;
    const int it = F.vcu * 4 + (F.wave >> 1);
    LAS float* xch = (LAS float*)(F.lds + RING_OFF) + (F.wave >> 1) * 80;
    float mrun = -1e30f, sum = 0.f; float o[16];
#pragma unroll
    for (int k = 0; k < 16; ++k) o[k] = 0.f;
    const bool live = it < M_SAMPLE * 8;
    const int m = M_PROMPT + (live ? (it >> 3) : 0), j = it & 7, bs = (m - M_PROMPT) >> 2, tl = (m - M_PROMPT) & 3;
    if (live) {
        SaPass PA = sa_load(half, a, Q, K, V, m, j, bs, tl, ksub, part);
#pragma unroll 1
        for (int idx = half; idx < 27; idx += 2) {
            const int nx = (idx + 2 < 27) ? idx + 2 : idx;
            const SaPass PB = sa_load(nx, a, Q, K, V, m, j, bs, tl, ksub, part);
            sa_proc(PA, idx, a, j, bs, tl, ksub, part, mrun, sum, o);
            PA = PB;
        }
    }
    const float M = wave_max(mrun), fl = __expf(mrun - M);
    sum *= fl;
#pragma unroll
    for (int k = 0; k < 16; ++k) o[k] *= fl;
#pragma unroll
    for (int off = 4; off < 64; off <<= 1) {
        sum += __shfl_xor(sum, off);
#pragma unroll
        for (int k = 0; k < 16; ++k) o[k] += __shfl_xor(o[k], off);
    }
    if (half == 1 && ksub == 0) { xch[part * 18] = M; xch[part * 18 + 1] = sum;
#pragma unroll
        for (int k = 0; k < 16; ++k) xch[part * 18 + 2 + k] = o[k]; }
    __syncthreads();
    if (half == 0 && ksub == 0 && live) {
        const float M1 = xch[part * 18], s1 = xch[part * 18 + 1];
        const float Mn = fmaxf(M, M1), f0 = __expf(M - Mn), f1 = __expf(M1 - Mn);
        const float rl = 1.0f / (sum * f0 + s1 * f1);
        float r[16];
#pragma unroll
        for (int k = 0; k < 16; ++k) r[k] = (o[k] * f0 + xch[part * 18 + 2 + k] * f1) * rl;
        v4u o0, o1; o0.x = pk2(r[0], r[1]); o0.y = pk2(r[2], r[3]); o0.z = pk2(r[4], r[5]); o0.w = pk2(r[6], r[7]);
        o1.x = pk2(r[8], r[9]); o1.y = pk2(r[10], r[11]); o1.z = pk2(r[12], r[13]); o1.w = pk2(r[14], r[15]);
        GAS v4u* op = (GAS v4u*)(Bb + (size_t)m * D_A + j * HD + 16 * part); op[0] = o0; op[1] = o1;
    }
    __syncthreads();
}

__device__ __forceinline__ void p3_combine(const Frame& F, const Args& a) {
    unsigned char* ws = a.ws;
    const bf16* OG = (const bf16*)(ws + WS_OG); const float* LSE = (const float*)(ws + WS_LSE); bf16* Bb = (bf16*)(ws + WS_B);
    const size_t gt = (size_t)blockIdx.x * 512 + F.tid, NT = (size_t)F.G * 512, total = (size_t)M_PROMPT * 64;
    for (size_t i0 = gt; i0 < total; i0 += 8 * NT) {
        v4u a0[8], a1[8], a2[8]; float l0[8], l1[8], l2[8];
#pragma unroll
        for (int k = 0; k < 8; ++k) { const size_t i = i0 + k * NT; if (i < total) { const size_t m = i >> 6; const int c8 = (int)(i & 63), j = c8 >> 3;
            l0[k] = LSE[((size_t)0 * M_PROMPT + m) * 8 + j]; l1[k] = LSE[((size_t)1 * M_PROMPT + m) * 8 + j]; l2[k] = LSE[((size_t)2 * M_PROMPT + m) * 8 + j];
            a0[k] = ((const GAS v4u*)(OG + ((size_t)0 * M_PROMPT + m) * 512))[c8]; a1[k] = ((const GAS v4u*)(OG + ((size_t)1 * M_PROMPT + m) * 512))[c8]; a2[k] = ((const GAS v4u*)(OG + ((size_t)2 * M_PROMPT + m) * 512))[c8]; } }
#pragma unroll
        for (int k = 0; k < 8; ++k) { const size_t i = i0 + k * NT; if (i < total) { const size_t m = i >> 6; const int c8 = (int)(i & 63);
            const float mx = fmaxf(l0[k], fmaxf(l1[k], l2[k]));
            float w0 = __builtin_amdgcn_exp2f(l0[k] - mx), w1 = __builtin_amdgcn_exp2f(l1[k] - mx), w2 = __builtin_amdgcn_exp2f(l2[k] - mx);
            const float rs = 1.0f / (w0 + w1 + w2); w0 *= rs; w1 *= rs; w2 *= rs;
            const v4u x0 = a0[k], x1 = a1[k], x2 = a2[k];
            v4u o;
            o.x = pk2(w0 * bflo(x0.x) + w1 * bflo(x1.x) + w2 * bflo(x2.x), w0 * bfhi(x0.x) + w1 * bfhi(x1.x) + w2 * bfhi(x2.x));
            o.y = pk2(w0 * bflo(x0.y) + w1 * bflo(x1.y) + w2 * bflo(x2.y), w0 * bfhi(x0.y) + w1 * bfhi(x1.y) + w2 * bfhi(x2.y));
            o.z = pk2(w0 * bflo(x0.z) + w1 * bflo(x1.z) + w2 * bflo(x2.z), w0 * bfhi(x0.z) + w1 * bfhi(x1.z) + w2 * bfhi(x2.z));
            o.w = pk2(w0 * bflo(x0.w) + w1 * bflo(x1.w) + w2 * bflo(x2.w), w0 * bfhi(x0.w) + w1 * bfhi(x1.w) + w2 * bfhi(x2.w));
            ((GAS v4u*)(Bb + m * 512))[c8] = o; } }
    }
}

constexpr int MX_V = 0;
__device__ __forceinline__ float ssv_rstd(const float* SSV, int m) {
    const f32x4 s0 = ((const GAS f32x4*)(SSV + (size_t)m * 8))[0], s1 = ((const GAS f32x4*)(SSV + (size_t)m * 8))[1];
    const float ss = ((s0.x + s0.y) + (s0.z + s0.w)) + ((s1.x + s1.y) + (s1.z + s1.w));
    return __builtin_amdgcn_rsqf(ss * (1.f / D_A) + EPS);
}
constexpr int MX_C = 32768, MX_CLD = 132;
__device__ __forceinline__ void p3_mix(const Frame& F, const Args& a) {
    unsigned char* ws = a.ws;
    const bf16* U = (const bf16*)(ws + WS_U); const bf16* VA = (const bf16*)(ws + WS_VA); const bf16* WSB = (const bf16*)(ws + WS_WSB); const float* SSV = (const float*)(ws + WS_SSV);
    bf16* Ab = (bf16*)(ws + WS_A);
    const float* g_v = a.in[9]; const float* b_s = a.in[11];
    const int tid = F.tid, lane = F.lane, w = F.wave, l31 = lane & 31, hi = lane >> 5;
    const LAS unsigned char* ldsV = F.lds + MX_V;
    LAS float* ldsC = (LAS float*)(F.lds + MX_C);
    const int tb = w >> 1, cb = w & 1;
    auto LOAD = [&](int it, v4u (&x)[4], v4u (&u)[4], float (&rs)[4], float (&bi)[4]) {
        const int g = it & 3, chunk0 = (it >> 2) * 128;
#pragma unroll
        for (int k = 0; k < 4; ++k) { const int cidx = tid + 512 * k, s = cidx >> 4, c = cidx & 15; const size_t off = (size_t)(chunk0 + s) * D_A + g * 128 + c * 8;
            x[k] = *(const GAS v4u*)(VA + off); u[k] = *(const GAS v4u*)(U + off); rs[k] = ssv_rstd(SSV, chunk0 + s); bi[k] = b_s[g * 128 + s]; }
    };
    auto PROC = [&](int it, const v4u (&xx)[4], const v4u (&uu)[4], const float (&rsv)[4], const float (&bi)[4]) {
        const int g = it & 3, ck = it >> 2, chunk0 = ck * 128;
        const bool lastc = (ck & 31) == 31; const int bb = ck >> 5;
        const bf16* wrow = WSB + ((size_t)g * 128 + 32 * tb + l31) * 128 + 4 * hi;
        v2u wa[8][2];
#pragma unroll
        for (int ks = 0; ks < 8; ++ks) if (ks <= 2 * tb + 1) { wa[ks][0] = *(const GAS v2u*)(wrow + 16 * ks); wa[ks][1] = *(const GAS v2u*)(wrow + 16 * ks + 8); }
#pragma unroll
        for (int k = 0; k < 4; ++k) {
            const int cidx = tid + 512 * k, s = cidx >> 4, c = cidx & 15;
            const float rs = rsv[k]; const v4u x = xx[k];
            const f32x4 g0 = *(const GAS f32x4*)(g_v + g * 128 + c * 8), g1 = *(const GAS f32x4*)(g_v + g * 128 + c * 8 + 4);
            const float v0 = bflo(x.x) * rs * g0.x, v1 = bfhi(x.x) * rs * g0.y, v2 = bflo(x.y) * rs * g0.z, v3 = bfhi(x.y) * rs * g0.w;
            const float v4 = bflo(x.z) * rs * g1.x, v5 = bfhi(x.z) * rs * g1.y, v6 = bflo(x.w) * rs * g1.z, v7 = bfhi(x.w) * rs * g1.w;
            v4u o; o.x = pk2(v0, v1); o.y = pk2(v2, v3); o.z = pk2(v4, v5); o.w = pk2(v6, v7);
            *(LAS v4u*)(F.lds + MX_V + ((s >> 3) * 4 + (c >> 2)) * 512 + (s & 7) * 64 + (c & 3) * 16) = o;
            if (lastc) { float* cv = a.out + O_CVP + ((size_t)bb * 128 + s) * D_A + g * 128 + c * 8; *(GAS f32x4*)cv = (f32x4){v0, v1, v2, v3}; *(GAS f32x4*)(cv + 4) = (f32x4){v4, v5, v6, v7}; }
        }
        __syncthreads();
        f32x16 C[2];
        C[0] = (f32x16){0.f,0.f,0.f,0.f,0.f,0.f,0.f,0.f,0.f,0.f,0.f,0.f,0.f,0.f,0.f,0.f}; C[1] = C[0];
        const int vbase = (4 * hi + ((lane & 15) >> 2)) * 64 + ((lane >> 4) & 1) * 32 + (lane & 3) * 8;
#pragma unroll
        for (int ks = 0; ks < 8; ++ks) {
            if (ks <= 2 * tb + 1) {
                const bf16x8_t af = __builtin_bit_cast(bf16x8_t, (v4u){wa[ks][0].x, wa[ks][0].y, wa[ks][1].x, wa[ks][1].y});
#pragma unroll
                for (int nb = 0; nb < 2; ++nb) {
                    const int st = (2 * ks) * 4 + (2 * cb + nb);
                    const s16x4_t lo = vtr(ldsV + st * 512 + vbase), hv = vtr(ldsV + (st + 4) * 512 + vbase);
                    const bf16x8_t vb = (bf16x8_t){lo[0], lo[1], lo[2], lo[3], hv[0], hv[1], hv[2], hv[3]};
                    C[nb] = __builtin_amdgcn_mfma_f32_32x32x16_bf16(af, vb, C[nb], 0, 0, 0);
                }
            }
        }
#pragma unroll
        for (int rr = 0; rr < 16; ++rr) { const int t = 32 * tb + crow(rr, hi);
#pragma unroll
            for (int nb = 0; nb < 2; ++nb) ldsC[t * MX_CLD + 64 * cb + 32 * nb + l31] = C[nb][rr]; }
        __syncthreads();
#pragma unroll
        for (int k = 0; k < 4; ++k) {
            const int cidx = tid + 512 * k, s = cidx >> 4, c = cidx & 15;
            const f32x4 m0 = *(const LAS f32x4*)(ldsC + s * MX_CLD + c * 8), m1 = *(const LAS f32x4*)(ldsC + s * MX_CLD + c * 8 + 4);
            const v4u u = uu[k]; const float b = bi[k];
            v4u o; o.x = pk2(bflo(u.x) * (m0.x + b), bfhi(u.x) * (m0.y + b)); o.y = pk2(bflo(u.y) * (m0.z + b), bfhi(u.y) * (m0.w + b));
            o.z = pk2(bflo(u.z) * (m1.x + b), bfhi(u.z) * (m1.y + b)); o.w = pk2(bflo(u.w) * (m1.z + b), bfhi(u.w) * (m1.w + b));
            *(GAS v4u*)(Ab + (size_t)(chunk0 + s) * D_A + g * 128 + c * 8) = o;
        }
    };
    v4u xa[4], ua[4], xb[4], ub[4]; float ra[4], ba[4], rb[4], bb2[4];
    int it = F.vcu;
    if (it < 512) {
        LOAD(it, xa, ua, ra, ba);
        for (;;) {
            int n = it + F.G; bool hn = n < 512;
            if (hn) LOAD(n, xb, ub, rb, bb2);
            PROC(it, xa, ua, ra, ba);
            if (!hn) break;
            it = n; n = it + F.G; hn = n < 512;
            if (hn) LOAD(n, xa, ua, ra, ba);
            PROC(it, xb, ub, rb, bb2);
            if (!hn) break;
            it = n;
        }
    }
    __syncthreads();
}
__device__ __forceinline__ void p3_mix_sample(const Frame& F, const Args& a) {
    unsigned char* ws = a.ws;
    const int gw = F.vcu * NWAVES + F.wave, NGW = F.G * NWAVES, lane = F.lane;
    const bf16* U = (const bf16*)(ws + WS_U); const bf16* VA = (const bf16*)(ws + WS_VA); const float* SSV = (const float*)(ws + WS_SSV);
    bf16* Ab = (bf16*)(ws + WS_A);
    const float* w_s = a.in[10]; const float* b_s = a.in[11]; const float* g_v = a.in[9];
    for (int it = gw; it < M_SAMPLE * 4; it += NGW) {
        const int m = M_PROMPT + (it >> 2), g = it & 3;
        const int chunk0 = M_PROMPT + ((m - M_PROMPT) & ~3), tl = (m - M_PROMPT) & 3;
        const float gv0 = g_v[g * 128 + 2 * lane], gv1 = g_v[g * 128 + 2 * lane + 1];
        float acc0 = 0.f, acc1 = 0.f;
        const float* wrow = w_s + ((size_t)g * 128 + tl) * 128;
        float wv[4], rs[4]; unsigned vv[4];
#pragma unroll
        for (int s = 0; s < 4; ++s) { const int sc = s <= tl ? s : tl; wv[s] = wrow[sc]; rs[s] = ssv_rstd(SSV, chunk0 + sc); vv[s] = ((const GAS unsigned*)(VA + (size_t)(chunk0 + sc) * D_A + g * 128))[lane]; }
        const float bias = b_s[g * 128 + tl];
        const unsigned uu = ((const GAS unsigned*)(U + (size_t)m * D_A + g * 128))[lane];
#pragma unroll
        for (int s = 0; s < 4; ++s) if (s <= tl) {
            const float n0 = bflo(vv[s]) * rs[s] * gv0, n1 = bfhi(vv[s]) * rs[s] * gv1;
            acc0 += wv[s] * bf2f((unsigned short)f2bf(n0)); acc1 += wv[s] * bf2f((unsigned short)f2bf(n1));
            if (s == tl) { float* cv = a.out + O_CVS + (size_t)(m - M_PROMPT) * D_A + g * 128 + 2 * lane; cv[0] = n0; cv[1] = n1; }
        }
        ((GAS unsigned*)(Ab + (size_t)m * D_A + g * 128))[lane] = pk2(bflo(uu) * (acc0 + bias), bfhi(uu) * (acc1 + bias));
    }
}

#define SG_ROWS() const int lane = F.lane, w = F.wave, tok = lane & 15, fq = lane >> 4, sidx = 16 * w + tok, m = M_PROMPT + sidx; (void)tok
#define SG_TILE(rg, cg) const int lane = F.lane, w = F.wave, tok = lane & 15, fq = lane >> 4, sidx = 32 * (rg) + 16 * (w >> 2) + tok, m = M_PROMPT + sidx, c0 = 64 * (cg) + 16 * (w & 3), r0s = 32 * (rg), cg0 = 64 * (cg); LAS float* red = (LAS float*)(F.lds + RING_OFF); (void)tok; (void)m
__device__ __forceinline__ void s1_job(const Frame& F, const Args& a, int cb) {
    unsigned char* ws = a.ws; SG_ROWS();
    sg::f32x4 acc[4]; float ssu = 0.f;
#pragma unroll
    for (int nt = 0; nt < 4; ++nt) acc[nt] = (sg::f32x4){0.f, 0.f, 0.f, 0.f};
    sg::core<4, false>(acc, ssu, ws + WS_H, D, m, (const unsigned short*)(ws + WS_WIN), D, 64 * cb, 0, D, lane);
    const int b = sidx >> 2, tl = sidx & 3;
    if (cb < 8) {
#pragma unroll
        for (int nt = 0; nt < 4; ++nt) { v2u o; o.x = sg::cvt2(sg::gelu(acc[nt][0]), sg::gelu(acc[nt][1])); o.y = sg::cvt2(sg::gelu(acc[nt][2]), sg::gelu(acc[nt][3]));
            *(GAS v2u*)((bf16*)(ws + WS_U) + (size_t)m * D_A + 64 * cb + 16 * nt + 4 * fq) = o; }
    } else if (cb < 16) {
        float ss = 0.f;
#pragma unroll
        for (int nt = 0; nt < 4; ++nt) { const float g0 = sg::gelu(acc[nt][0]), g1 = sg::gelu(acc[nt][1]), g2 = sg::gelu(acc[nt][2]), g3 = sg::gelu(acc[nt][3]);
            ss += (g0 * g0 + g1 * g1) + (g2 * g2 + g3 * g3); v2u o; o.x = sg::cvt2(g0, g1); o.y = sg::cvt2(g2, g3);
            *(GAS v2u*)((bf16*)(ws + WS_VA) + (size_t)m * D_A + 64 * (cb - 8) + 16 * nt + 4 * fq) = o; }
        ss += __shfl_xor(ss, 16); ss += __shfl_xor(ss, 32);
        if (fq == 0) ((float*)(ws + WS_SSV))[(size_t)m * 8 + (cb - 8)] = ss;
    } else if (cb < 88) {
        const bool isv = cb >= 64, isk = !isv && cb >= 40; const int hd = cb - (isv ? 64 : isk ? 40 : 16), g = hd >> 3, hh = hd & 7;
        float y[4][4];
#pragma unroll
        for (int nt = 0; nt < 4; ++nt)
#pragma unroll
            for (int r = 0; r < 4; ++r) y[nt][r] = acc[nt][r];
        if (!isv) {
            float ss = 0.f;
#pragma unroll
            for (int nt = 0; nt < 4; ++nt) ss += (y[nt][0] * y[nt][0] + y[nt][1] * y[nt][1]) + (y[nt][2] * y[nt][2] + y[nt][3] * y[nt][3]);
            ss += __shfl_xor(ss, 16); ss += __shfl_xor(ss, 32);
            const float rn = __builtin_amdgcn_rsqf(ss * (1.f / HD) + EPS);
            const float* gp = isk ? a.in[13] : a.in[12];
#pragma unroll
            for (int nt = 0; nt < 4; ++nt) { const f32x4 gg = *(const GAS f32x4*)(gp + 16 * nt + 4 * fq); y[nt][0] *= rn * gg.x; y[nt][1] *= rn * gg.y; y[nt][2] *= rn * gg.z; y[nt][3] *= rn * gg.w; }
            const float* rt = (const float*)(ws + WS_ROT) + (size_t)(4096 + tl) * 16 + 8 * (fq & 1);
            const f32x4 t0 = *(const GAS f32x4*)rt, t1 = *(const GAS f32x4*)(rt + 4);
            const float cs[4] = {t0.x, t0.z, t1.x, t1.z}, sn[4] = {t0.y, t0.w, t1.y, t1.w};
#pragma unroll
            for (int r = 0; r < 4; ++r) { const float pr = __shfl_xor(y[0][r], 32); y[0][r] = (fq < 2) ? (y[0][r] * cs[r] - pr * sn[r]) : (y[0][r] * cs[r] + pr * sn[r]); }
        }
        bf16* dst = (bf16*)(ws + (isv ? WS_V : isk ? WS_K : WS_Q)) + (size_t)m * DQKV + hd * HD;
#pragma unroll
        for (int nt = 0; nt < 4; ++nt) { v2u o; o.x = sg::cvt2(y[nt][0], y[nt][1]); o.y = sg::cvt2(y[nt][2], y[nt][3]); *(GAS v2u*)(dst + 16 * nt + 4 * fq) = o; }
        if (isk || isv) {
            const int W = 128 << (2 * g); const size_t oks = (g == 0) ? O_KV128S : (g == 1) ? O_KV512S : O_KV2048S;
            float* o = a.out + oks + ((((size_t)b * 2 + (isv ? 1 : 0)) * W + (W - DEC_T + tl)) * 8 + hh) * HD + 4 * fq;
#pragma unroll
            for (int nt = 0; nt < 4; ++nt) *(GAS f32x4*)(o + 16 * nt) = (f32x4){y[nt][0], y[nt][1], y[nt][2], y[nt][3]};
        }
    } else {
        bf16* dst = (bf16*)(ws + (cb < 104 ? WS_GA : WS_GB)) + (size_t)m * D + 64 * (cb - (cb < 104 ? 88 : 104));
#pragma unroll
        for (int nt = 0; nt < 4; ++nt) { v2u o; o.x = sg::cvt2(sg::sigm(acc[nt][0]), sg::sigm(acc[nt][1])); o.y = sg::cvt2(sg::sigm(acc[nt][2]), sg::sigm(acc[nt][3]));
            *(GAS v2u*)(dst + 16 * nt + 4 * fq) = o; }
    }
}
__device__ __forceinline__ void s3_job(const Frame& F, const Args& a, int j) {
    unsigned char* ws = a.ws; const int which = j & 1, rg = (j >> 1) & 3, cg = j >> 3; SG_TILE(rg, cg);
    sg::f32x4 acc[1]; float ssu = 0.f;
    sg::core8<false, 2>(acc[0], ssu, red, ws + (which ? WS_B : WS_A), D_A, M_PROMPT + r0s, (const unsigned short*)(ws + (which ? WS_WOB : WS_WOA)), D_A, cg0, 0, lane, w);
    const v2u gt = *(const GAS v2u*)((const bf16*)(ws + (which ? WS_GB : WS_GA)) + (size_t)m * D + c0 + 4 * fq);
    float* o = (float*)(ws + WS_MGS) + (size_t)sidx * D + c0 + 4 * fq;
    atomicAdd(o + 0, bflo(gt.x) * acc[0][0]); atomicAdd(o + 1, bfhi(gt.x) * acc[0][1]); atomicAdd(o + 2, bflo(gt.y) * acc[0][2]); atomicAdd(o + 3, bfhi(gt.y) * acc[0][3]);
}
__device__ __forceinline__ void s4_job(const Frame& F, const Args& a, int j) {
    unsigned char* ws = a.ws; const int kq = j & 3, rg = (j >> 2) & 3, cg = j >> 4; SG_TILE(rg, cg);
    sg::f32x4 acc[1]; float ssu = 0.f;
    sg::core8<true, 1>(acc[0], ssu, red, ws + WS_MGS, D, r0s, (const unsigned short*)(ws + WS_WO), D, cg0, 256 * kq, lane, w);
    float* o = (float*)(ws + WS_X1S) + (size_t)sidx * D + c0 + 4 * fq;
    atomicAdd(o + 0, acc[0][0]); atomicAdd(o + 1, acc[0][1]); atomicAdd(o + 2, acc[0][2]); atomicAdd(o + 3, acc[0][3]);
}
__device__ __forceinline__ void s5_job(const Frame& F, const Args& a, int j) {
    unsigned char* ws = a.ws; const int rg = j & 3, cg = j >> 2; SG_TILE(rg, cg);
    sg::f32x4 acc[1]; float ss = 0.f;
    sg::core8<true, 4>(acc[0], ss, red, ws + WS_X1S, D, r0s, (const unsigned short*)(ws + WS_WFF1), D, cg0, 0, lane, w);
    const float r = __builtin_amdgcn_rsqf(ss * (1.f / D) + EPS);
    float fv[4];
#pragma unroll
    for (int e = 0; e < 4; ++e) { const float t = fmaxf(acc[0][e] * r, 0.f); fv[e] = t * t; }
    v2u o; o.x = sg::cvt2(fv[0], fv[1]); o.y = sg::cvt2(fv[2], fv[3]);
    *(GAS v2u*)((bf16*)(ws + WS_F) + (size_t)m * D_FF + c0 + 4 * fq) = o;
    { const int row = F.tid >> 2, col = 4 * j + (F.tid & 3); ((float*)(ws + WS_X2S))[(size_t)row * D + col] = ((const float*)(ws + WS_X1S))[(size_t)row * D + col]; }
}
__device__ __forceinline__ void s6_job(const Frame& F, const Args& a, int j) {
    unsigned char* ws = a.ws; const int kq = j & 3, rg = (j >> 2) & 3, cg = j >> 4; SG_TILE(rg, cg);
    sg::f32x4 acc[1]; float ssu = 0.f;
    sg::core8<false, 4>(acc[0], ssu, red, ws + WS_F, D_FF, M_PROMPT + r0s, (const unsigned short*)(ws + WS_WFF2), D_FF, cg0, 1024 * kq, lane, w);
    float* o = (float*)(ws + WS_X2S) + (size_t)sidx * D + c0 + 4 * fq;
    atomicAdd(o + 0, acc[0][0]); atomicAdd(o + 1, acc[0][1]); atomicAdd(o + 2, acc[0][2]); atomicAdd(o + 3, acc[0][3]);
}
__device__ __forceinline__ void s7_job(const Frame& F, const Args& a, int j) {
    unsigned char* ws = a.ws; const int rg = j & 3, cg = j >> 2; SG_TILE(rg, cg);
    sg::f32x4 acc1[1], acc2[1]; float ss = 0.f, ssu = 0.f;
    sg::core8<true, 4>(acc1[0], ss, red, ws + WS_X2S, D, r0s, (const unsigned short*)(ws + WS_WPG), D, cg0, 0, lane, w);
    sg::core8<false, 1>(acc2[0], ssu, red, ws + WS_PE, D_PLE, M_PROMPT + r0s, (const unsigned short*)(ws + WS_WPP), D_PLE, cg0, 0, lane, w);
    const float r = __builtin_amdgcn_rsqf(ss * (1.f / D) + EPS);
    const size_t off = (size_t)sidx * D + c0 + 4 * fq;
    const f32x4 x2 = *(const GAS f32x4*)((const float*)(ws + WS_X2S) + off);
    f32x4 y; y.x = x2.x + sg::sigm(acc1[0][0] * r) * acc2[0][0]; y.y = x2.y + sg::sigm(acc1[0][1] * r) * acc2[0][1]; y.z = x2.z + sg::sigm(acc1[0][2] * r) * acc2[0][2]; y.w = x2.w + sg::sigm(acc1[0][3] * r) * acc2[0][3];
    *(GAS f32x4*)(a.out + O_YS + off) = y;
}

__global__ void __launch_bounds__(NWAVES * 64, 2) mega_fwd(Args args) {
    extern __shared__ __attribute__((aligned(16))) unsigned char lds[];
    Frame F;
    F.lds = (LAS unsigned char*)lds;
    F.tid = threadIdx.x; F.lane = F.tid & 63; F.wave = __builtin_amdgcn_readfirstlane(F.tid >> 6);
    F.G = gridDim.x; { const int bx = blockIdx.x; F.vcu = (F.G % 8 == 0) ? (bx % 8) * (F.G / 8) + bx / 8 : bx; }
#define REFRAME() do { int t_ = threadIdx.x; asm volatile("" : "+v"(t_)); F.tid = t_; F.lane = t_ & 63; F.wave = __builtin_amdgcn_readfirstlane(t_ >> 6); } while (0)
    unsigned char* ws = args.ws;
    for (int u = F.tid; u < (LDS_BYTES - LDSCTL_OFF) / 4; u += NWAVES * 64) ((LAS unsigned*)(F.lds + LDSCTL_OFF))[u] = 0u;
    __syncthreads();
    volatile LAS unsigned* MISC = (volatile LAS unsigned*)(F.lds + MISC_OFF);
    XcdBarrier bar = xcd_barrier_post((unsigned*)(ws + WS_CTL) + CW_BAR, MISC + 8);
    int bar_i = 0;
#define GRID_BAR(BN) do { xcd_barrier<BN>(bar, args.in[6], args.out, (long)bar_i * (256 * 448) + (long)blockIdx.x * (448 * (BN))); bar_i += (BN); } while (0)
    const int G = F.G, bx = (int)blockIdx.x;

    REFRAME();
    p0_prologue(F, args);
    GRID_BAR(8);
    { pg8::Gemm g{(const pg8::bf16_t*)(ws + WS_PE), (const pg8::bf16_t*)(ws + WS_WPP), M_PROMPT, D, D_PLE}; pg8::HalfOrder S{bx - 128};
      pg8::EpiGate<2> E{(bf16*)(ws + WS_PJB), nullptr, nullptr, D};
      pg8::gemm_phase<pg8::EpiGate<2>, pg8::HalfOrder, true, true, pg8::KvCopy>(F.lds + RING_OFF, g, S, E, pg8::KvCopy{{args.in[6], args.out, pg8::KVC_TOTAL, {}}, 1920}); }
    { pg8::Gemm g{(const pg8::bf16_t*)(ws + WS_H), (const pg8::bf16_t*)(ws + WS_WIN), M_PROMPT, D_IN, D}; pg8::StaticOrder S; S.init(M_PROMPT, D_IN, G, bx);
      pg8::EpiIn E{ws, args.out, args.in[12], args.in[13], (PG8_LAS float*)(F.lds + ROTT_OFF)};
      pg8::gemm_phase<pg8::EpiIn, pg8::StaticOrder, true, true, pg8::KvCopy>(F.lds + RING_OFF, g, S, E, pg8::KvCopy{{args.in[6], args.out, pg8::KVC_TOTAL, {}}, 0}); }
    REFRAME(); if (bx >= 128 && bx < 128 + 120) s1_job(F, args, bx - 128);
    GRID_BAR(28);
    REFRAME(); p3_swa(F, args);
    REFRAME(); p3_sample_attn(F, args);
    REFRAME(); p3_mix(F, args);
    REFRAME(); p3_mix_sample(F, args);
    GRID_BAR(28);
    { pg8::Gemm g{(const pg8::bf16_t*)(ws + WS_A), (const pg8::bf16_t*)(ws + WS_WOA), M_PROMPT, D, D_A}; pg8::StaticOrder S; S.init(M_PROMPT, D, G, bx);
      pg8::EpiGate<0> E{(bf16*)(ws + WS_T1B), (const bf16*)(ws + WS_GA), nullptr, D};
      pg8::gemm_phase<pg8::EpiGate<0>, pg8::StaticOrder, true, true, pg8::KvCopy>(F.lds + RING_OFF, g, S, E, pg8::KvCopy{{args.in[6], args.out, pg8::KVC_TOTAL, {}}, 2176}); }
    REFRAME(); p3_combine(F, args);
    REFRAME(); if (bx < 128) s3_job(F, args, bx);
    GRID_BAR(8);
    { pg8::Gemm g{(const pg8::bf16_t*)(ws + WS_B), (const pg8::bf16_t*)(ws + WS_WOB), M_PROMPT, D, D_A}; pg8::StaticOrder S; S.init(M_PROMPT, D, G, bx);
      pg8::EpiGate<1> E{(bf16*)(ws + WS_MG), (const bf16*)(ws + WS_GB), (const bf16*)(ws + WS_T1B), D};
      pg8::gemm_phase<pg8::EpiGate<1>, pg8::StaticOrder, true, true, pg8::KvCopy>(F.lds + RING_OFF, g, S, E, pg8::KvCopy{{args.in[6], args.out, pg8::KVC_TOTAL, {}}, 2432}); }
    REFRAME(); s4_job(F, args, bx);
    GRID_BAR(10);
    { pg8::Gemm g{(const pg8::bf16_t*)(ws + WS_MG), (const pg8::bf16_t*)(ws + WS_WO), M_PROMPT, D, D}; pg8::StaticOrder S; S.init(M_PROMPT, D, G, bx);
      pg8::EpiResid<false> E{args.in[0], (bf16*)(ws + WS_XB1), (float*)(ws + WS_SSQ1), nullptr};
      pg8::gemm_phase<pg8::EpiResid<false>, pg8::StaticOrder, true, true, pg8::KvCopy>(F.lds + RING_OFF, g, S, E, pg8::KvCopy{{args.in[6], args.out, pg8::KVC_TOTAL, {}}, 2688}); }
    REFRAME(); s5_job(F, args, bx);
    GRID_BAR(10);
    { pg8::Gemm g{(const pg8::bf16_t*)(ws + WS_XB1), (const pg8::bf16_t*)(ws + WS_WFF1), M_PROMPT, D_FF, D}; pg8::StaticOrder S; S.init(M_PROMPT, D_FF, G, bx);
      pg8::EpiFF1 E{(bf16*)(ws + WS_F), D_FF};
      pg8::gemm_phase<pg8::EpiFF1, pg8::StaticOrder, true, true, pg8::KvCopy>(F.lds + RING_OFF, g, S, E, pg8::KvCopy{{args.in[6], args.out, pg8::KVC_TOTAL, {}}, 2944}); }
    REFRAME(); s6_job(F, args, bx);
    GRID_BAR(10);
    { pg8::Gemm g{(const pg8::bf16_t*)(ws + WS_F), (const pg8::bf16_t*)(ws + WS_WFF2), M_PROMPT, D, D_FF}; pg8::StaticOrder S; S.init(M_PROMPT, D, G, bx);
      pg8::EpiResid<true> E{ws + WS_XB1, (bf16*)(ws + WS_XB2), (float*)(ws + WS_SSQ2), (const float*)(ws + WS_SSQ1)};
      pg8::gemm_phase<pg8::EpiResid<true>, pg8::StaticOrder, true, true, pg8::KvCopy>(F.lds + RING_OFF, g, S, E, pg8::KvCopy{{args.in[6], args.out, pg8::KVC_TOTAL, {}}, 3968}); }
    REFRAME(); if (bx < 64) s7_job(F, args, bx);
    GRID_BAR(10);
    { pg8::Gemm g{(const pg8::bf16_t*)(ws + WS_XB2), (const pg8::bf16_t*)(ws + WS_WPG), M_PROMPT, D, D}; pg8::StaticOrder S; S.init(M_PROMPT, D, G, bx);
      pg8::EpiFinal E{args.out, (const bf16*)(ws + WS_XB2), (const bf16*)(ws + WS_PJB), (const float*)(ws + WS_SSQ2)};
      pg8::gemm_phase<pg8::EpiFinal, pg8::StaticOrder, true, true, pg8::KvCopy>(F.lds + RING_OFF, g, S, E, pg8::KvCopy{{args.in[6], args.out, pg8::KVC_TOTAL, {}}, 4224}); }
}

extern "C" void kernel_launch(void* const* d_in, const int* in_sizes, int n_in, void* d_out, int out_size, void* d_ws, size_t ws_size, hipStream_t stream) {
    static int grid = 0;
    if (grid == 0) {
        if (n_in != 23 || out_size != (int)O_END || ws_size < WS_END2) { fprintf(stderr, "kernel_launch: unexpected shapes: n_in %d out %d ws %zu (need %zu)\n", n_in, out_size, ws_size, (size_t)WS_END2); grid = -1; return; }
        int dev = 0, cus = 0, per_cu = 0;
        if (hipGetDevice(&dev) != hipSuccess || hipDeviceGetAttribute(&cus, hipDeviceAttributeMultiprocessorCount, dev) != hipSuccess) { grid = -1; return; }
        if (hipFuncSetAttribute((const void*)mega_fwd, hipFuncAttributeMaxDynamicSharedMemorySize, LDS_BYTES) != hipSuccess) { fprintf(stderr, "kernel_launch: hipFuncSetAttribute failed\n"); grid = -1; return; }
        if (hipOccupancyMaxActiveBlocksPerMultiprocessor(&per_cu, (const void*)mega_fwd, NWAVES * 64, LDS_BYTES) != hipSuccess || per_cu < 1) { fprintf(stderr, "kernel_launch: occupancy query says %d blocks/CU\n", per_cu); }
        (void)hipGetLastError();
        grid = cus;
        if (grid != 256) { fprintf(stderr, "kernel_launch: this kernel's static work split needs 256 CUs, device has %d\n", cus); grid = -1; return; }
    }
    if (grid < 0) return;
    if (hipMemsetAsync((char*)d_ws + WS_CTL, 0, CTL_ZERO_BYTES, stream) != hipSuccess) { fprintf(stderr, "kernel_launch: memset failed\n"); return; }
    Args a{};
    for (int i = 0; i < 23; ++i) a.in[i] = (const float*)d_in[i];
    a.out = (float*)d_out; a.ws = (unsigned char*)d_ws;
    hipLaunchKernelGGL(mega_fwd, dim3(grid), dim3(NWAVES * 64), LDS_BYTES, stream, a);
}
```

```cpp
#include <hip/hip_runtime.h>
#include <cstdio>
#include <cstdint>
#include <cmath>
constexpr int NWAVES = 8;
constexpr int D = 1024, SEQ = 4096, NBATCH = 4, M_PROMPT = NBATCH * SEQ;
constexpr int DEC_B = 32, DEC_T = 4, M_SAMPLE = DEC_B * DEC_T;
constexpr int MV = M_PROMPT + M_SAMPLE;
constexpr int MP = 16640;
constexpr int PAST_LEN = 8192;
constexpr int D_A = 512, NHB = 24, HD = 64, DQKV = NHB * HD, D_IN = 2 * D_A + 3 * DQKV + 2 * D, D_FF = 4096, D_PLE = 256;
constexpr int C_U = 0, C_VA = 512, C_Q = 1024, C_K = 2560, C_V = 4096, C_GA = 5632, C_GB = 6656;
constexpr float EPS = 1e-6f;
static_assert(D_IN == 7680, "D_IN");

constexpr size_t O_YP = 0, O_YS = 16777216, O_KV128P = O_YS + 131072, O_KV512P = O_KV128P + 524288, O_KV2048P = O_KV512P + 2097152,
                 O_KV128S = O_KV2048P + 8388608, O_KV512S = O_KV128S + 4194304, O_KV2048S = O_KV512S + 16777216,
                 O_CVP = O_KV2048S + 67108864, O_CVS = O_CVP + 262144, O_END = O_CVS + 65536;
static_assert(O_END == 116326400, "out size");

constexpr size_t MiB = 1u << 20;
constexpr size_t WS_CTL = 0, CTL_ZERO_BYTES = 65536;
constexpr size_t WS_WIN = 2 * MiB, WS_WOA = 17 * MiB, WS_WOB = 18 * MiB, WS_WO = 19 * MiB, WS_WFF1 = 21 * MiB, WS_WFF2 = 29 * MiB, WS_WPG = 37 * MiB, WS_WPP = 39 * MiB;
constexpr size_t WS_H = 40 * MiB, WS_PE = 73 * MiB, WS_U = 82 * MiB, WS_VA = 99 * MiB, WS_Q = 116 * MiB, WS_K = 165 * MiB, WS_V = 214 * MiB;
constexpr size_t WS_F = WS_Q;
constexpr size_t WS_GA = 263 * MiB, WS_GB = 296 * MiB, WS_A = 329 * MiB, WS_B = 346 * MiB, WS_MG = 363 * MiB;
constexpr size_t WS_BIG = 396 * MiB;
constexpr size_t WS_T1 = WS_BIG + 70 * MiB, WS_T2 = WS_BIG + 135 * MiB, WS_PJ = WS_BIG + 200 * MiB, WS_FF = WS_BIG + 265 * MiB;
constexpr size_t WS_END = WS_BIG + 488 * MiB;
constexpr size_t WS_OG = WS_END;
constexpr size_t WS_LSE = WS_OG + 48 * MiB;
constexpr size_t WS_SSV = WS_LSE + 2 * MiB;
constexpr size_t WS_WSB = WS_SSV + 1 * MiB;
constexpr size_t WS_SSQ1 = WS_WSB + 1 * MiB, WS_SSQ2 = WS_SSQ1 + 2 * MiB;
constexpr size_t WS_ROT = WS_SSQ2 + 2 * MiB;
constexpr size_t WS_MGS = WS_ROT + 1 * MiB, WS_X1S = WS_MGS + 1 * MiB, WS_X2S = WS_X1S + 1 * MiB;
constexpr size_t WS_END2 = WS_X2S + 1 * MiB;
constexpr size_t WS_T1B = WS_BIG, WS_PJB = WS_BIG + 33 * MiB;
constexpr size_t WS_XB1 = WS_H, WS_XB2 = WS_MG;
static_assert((size_t)MP * 1024 * 2 <= 33 * MiB && (size_t)MP * 256 * 2 <= 9 * MiB && (size_t)MP * 512 * 2 <= 17 * MiB && (size_t)MP * 1536 * 2 <= 49 * MiB, "ws map 1");
static_assert((size_t)MP * 4096 * 2 <= 147 * MiB && (size_t)MP * 1024 * 4 <= 65 * MiB && (size_t)MP * 4096 * 4 <= 260 * MiB && (size_t)MP * 7680 * 4 <= 488 * MiB, "ws map 2");


constexpr int CW_BAR = 4096;

constexpr int RING_OFF = 0, RING_BYTES = 131072;
constexpr int LDSCTL_OFF = RING_BYTES, MISC_OFF = LDSCTL_OFF + 320;
constexpr int ROTT_OFF = LDSCTL_OFF + 1024, LDS_BYTES = ROTT_OFF + 16384 + 1024;


namespace pg8 {
#define PG8_LAS __attribute__((address_space(3)))
typedef unsigned short bf16_t;
typedef short bf16x8 __attribute__((ext_vector_type(8)));
typedef float f32x4 __attribute__((ext_vector_type(4)));
typedef unsigned u32x4 __attribute__((ext_vector_type(4)));
constexpr int BM = 256, BK = 64, HALF = 128, HTB = HALF * BK * 2  , STAGE_BYTES = 8 * HTB, NXCD = 8, WGM = 8;

__host__ __device__ __forceinline__ int lds_byte(int r, int c) { const int st = (r >> 4) * 2 + (c >> 5), rr = r & 15, cc = c & 31, ob = rr * 64 + cc * 2; return st * 1024 + (ob ^ (((ob >> 9) & 1) << 5)); }
__host__ __device__ __forceinline__ void stage_rc(int b, int& R, int& C) { const int st = b / 1024, sb = b % 1024, swz = sb ^ (((sb >> 9) & 1) << 5); R = (st >> 1) * 16 + swz / 64; C = (st & 1) * 32 + (swz % 64) / 2; }
__host__ __device__ __forceinline__ int perm32(int rho) { const int n = rho >> 4, i = rho & 15; return 8 * (i >> 2) + 4 * n + (i & 3); }

struct Unit { int pm, pn, L; };
struct Gemm { const bf16_t* A; const bf16_t* Bt; int M, N, K; };

struct StaticOrder {
    int nM, nN, nwg, G, c;
    __host__ __device__ void init(int M, int N, int G_, int c_) { nM = M / BM; nN = N / BM; nwg = nM * nN; G = G_; c = c_; }
    __host__ __device__ bool next(int i, Unit& u) const {
        const long L = (long)i * G + c; if (L >= nwg) return false; u.L = (int)L;
        int wgid = (int)L; { const int q = nwg / NXCD, r = nwg % NXCD, xcd = wgid % NXCD, off = wgid / NXCD; wgid = (xcd < r ? xcd * (q + 1) : r * (q + 1) + (xcd - r) * q) + off; }
        const int nig = WGM * nN, gid = wgid / nig, fm = gid * WGM, gsz = (nM - fm) < WGM ? (nM - fm) : WGM;
        u.pm = fm + ((wgid % nig) % gsz); u.pn = (wgid % nig) / gsz; return true;
    }
    __device__ __forceinline__ void a_ready(const Unit&) const {}
    __device__ __forceinline__ void done(const Unit&) const {}
};

__device__ __forceinline__ unsigned cvt_pk_bf16(float lo, float hi) { unsigned r; asm volatile("v_cvt_pk_bf16_f32 %0, %1, %2" : "=v"(r) : "v"(lo), "v"(hi)); return r; }
typedef float f32x2 __attribute__((ext_vector_type(2)));
struct EpiF32 {
    static constexpr bool PERM = false, AFTER_DRAIN = false, HEADMAP = false;
    float* C; int ldc; const float* bias;
    __device__ __forceinline__ void operator()(const f32x4 (&acc)[2][2][4][2], const Unit& u, int wr, int wc, int fr, int fq) const {
        const int row0 = u.pm * BM + wr * 64 + fr, col0 = u.pn * BM + wc * 32 + 4 * fq;
        f32x4 bv[2][2];
#pragma unroll
        for (int bj = 0; bj < 2; ++bj)
#pragma unroll
            for (int n = 0; n < 2; ++n) bv[bj][n] = bias ? *(const f32x4*)(bias + col0 + bj * HALF + n * 16) : (f32x4){0.f, 0.f, 0.f, 0.f};
#pragma unroll
        for (int ai = 0; ai < 2; ++ai)
#pragma unroll
            for (int m = 0; m < 4; ++m) { float* rowp = C + (size_t)(row0 + ai * HALF + m * 16) * ldc + col0;
#pragma unroll
                for (int bj = 0; bj < 2; ++bj)
#pragma unroll
                    for (int n = 0; n < 2; ++n) *(f32x4*)(rowp + bj * HALF + n * 16) = acc[ai][bj][m][n] + bv[bj][n]; }
    }
};
struct HalfOrder {
    int c2;
    __device__ __forceinline__ bool next(int i, Unit& u) const { if (c2 < 0 || i >= 2) return false; const int L = i * 128 + c2; u.pm = L >> 2; u.pn = L & 3; u.L = L; return true; }
    __device__ __forceinline__ void a_ready(const Unit&) const {}
    __device__ __forceinline__ void done(const Unit&) const {}
};
__device__ __forceinline__ float ep_sum_xor16(float x) { const unsigned xi = __builtin_bit_cast(unsigned, x); const auto r = __builtin_amdgcn_permlane16_swap(xi, xi, false, false); return __builtin_bit_cast(float, (unsigned)r[0]) + __builtin_bit_cast(float, (unsigned)r[1]); }
__device__ __forceinline__ float ep_sum_xor32(float x) { const unsigned xi = __builtin_bit_cast(unsigned, x); const auto r = __builtin_amdgcn_permlane32_swap(xi, xi, false, false); return __builtin_bit_cast(float, (unsigned)r[0]) + __builtin_bit_cast(float, (unsigned)r[1]); }
__device__ __forceinline__ float ep_get_xor16(float x, bool odd_row) { const unsigned xi = __builtin_bit_cast(unsigned, x); const auto r = __builtin_amdgcn_permlane16_swap(xi, xi, false, false); return __builtin_bit_cast(float, odd_row ? (unsigned)r[0] : (unsigned)r[1]); }
__device__ __forceinline__ float ep_sigmoid(float x) { return __builtin_amdgcn_rcpf(1.0f + __builtin_amdgcn_exp2f(-1.4426950408889634f * x)); }
__device__ __forceinline__ float ep_gelu(float x) { const float y = 0.7978845608028654f * (x + 0.044715f * x * x * x); return x * ep_sigmoid(2.0f * y); }
typedef __bf16 ep_bf16x2 __attribute__((ext_vector_type(2)));
__device__ __forceinline__ unsigned ep_cvt2(float lo, float hi) { f32x2 v = {lo, hi}; ep_bf16x2 b = __builtin_convertvector(v, ep_bf16x2); return __builtin_bit_cast(unsigned, b); }
__device__ __forceinline__ u32x4 ep_pack8(const float (&v)[8]) { u32x4 w; w.x = ep_cvt2(v[0], v[1]); w.y = ep_cvt2(v[2], v[3]); w.z = ep_cvt2(v[4], v[5]); w.w = ep_cvt2(v[6], v[7]); return w; }
__device__ __forceinline__ float ep_bflo(unsigned w) { return __builtin_bit_cast(float, w << 16); }
__device__ __forceinline__ float ep_bfhi(unsigned w) { return __builtin_bit_cast(float, w & 0xffff0000u); }
__device__ __forceinline__ void ep_unpack8(const u32x4 w, float (&v)[8]) { v[0] = ep_bflo(w.x); v[1] = ep_bfhi(w.x); v[2] = ep_bflo(w.y); v[3] = ep_bfhi(w.y); v[4] = ep_bflo(w.z); v[5] = ep_bfhi(w.z); v[6] = ep_bflo(w.w); v[7] = ep_bfhi(w.w); }
#define EP_X8(x, a_, b_) float x[8] = {a_[0], a_[1], a_[2], a_[3], b_[0], b_[1], b_[2], b_[3]}

constexpr int EP_MPROMPT = 16384, EP_MV = 16512, EP_SEQ = 4096, EP_DECT = 4;
__device__ __forceinline__ int ep_perm_row(int m, int g) {
    if (g == 0 || m >= EP_MPROMPT) return m;
    const int b = m >> 12, t = m & 4095, sh = (g == 1) ? 2 : 4;
    return (b << 12) + (t & ((1 << sh) - 1)) * (4096 >> sh) + (t >> sh);
}

struct EpiIn {
    static constexpr bool PERM = true, AFTER_DRAIN = false, HEADMAP = true;
    unsigned char* ws; float* out; const float* g_q; const float* g_k; PG8_LAS float* rott;
    __device__ __forceinline__ void state_out(const float (&y0)[8], const float (&y1)[8], int row, int g, int hh, int c, int fq) const {
        const int W = 128 << (2 * g);
        const size_t okp = (g == 0) ? O_KV128P : (g == 1) ? O_KV512P : O_KV2048P, oks = (g == 0) ? O_KV128S : (g == 1) ? O_KV512S : O_KV2048S;
        float* o = nullptr;
        if (row < EP_MPROMPT) { const int b = row >> 12, t = row & 4095; if (t >= EP_SEQ - W) o = out + okp + ((((size_t)b * 2 + c) * W + (t - (EP_SEQ - W))) * 8 + hh) * 64; }
        else if (row < EP_MV) { const int b = (row - EP_MPROMPT) >> 2, t = (row - EP_MPROMPT) & 3; o = out + oks + ((((size_t)b * 2 + c) * W + (W - EP_DECT + t)) * 8 + hh) * 64; }
        if (o) { o += 8 * fq; __builtin_nontemporal_store((f32x4){y0[0], y0[1], y0[2], y0[3]}, (f32x4*)o); __builtin_nontemporal_store((f32x4){y0[4], y0[5], y0[6], y0[7]}, (f32x4*)(o + 4));
                 __builtin_nontemporal_store((f32x4){y1[0], y1[1], y1[2], y1[3]}, (f32x4*)(o + 32)); __builtin_nontemporal_store((f32x4){y1[4], y1[5], y1[6], y1[7]}, (f32x4*)(o + 36)); }
    }
    __device__ __forceinline__ void operator()(const f32x4 (&acc)[2][2][4][2], const Unit& u, int wr, int wc, int fr, int fq) const {
        const int pn = u.pn, row0 = u.pm * BM + wr * 64 + fr, cw = 64 * wc + 8 * fq;
        bf16_t* const U = (bf16_t*)(ws + WS_U); bf16_t* const VA = (bf16_t*)(ws + WS_VA); bf16_t* const V = (bf16_t*)(ws + WS_V); float* const SSV = (float*)(ws + WS_SSV); const float* const ROT = (const float*)(ws + WS_ROT);
        if (pn < 2) {
#pragma unroll
            for (int ai = 0; ai < 2; ++ai)
#pragma unroll
                for (int m = 0; m < 4; ++m) { const int row = row0 + ai * HALF + m * 16;
#pragma unroll
                    for (int bj = 0; bj < 2; ++bj) { EP_X8(x, acc[ai][bj][m][0], acc[ai][bj][m][1]);
#pragma unroll
                        for (int e = 0; e < 8; ++e) x[e] = ep_gelu(x[e]);
                        *(u32x4*)(U + (size_t)row * 512 + 256 * pn + cw + 32 * bj) = ep_pack8(x); } }
        } else if (pn < 4) {
#pragma unroll
            for (int ai = 0; ai < 2; ++ai)
#pragma unroll
                for (int m = 0; m < 4; ++m) { const int row = row0 + ai * HALF + m * 16; float ss = 0.f;
#pragma unroll
                    for (int bj = 0; bj < 2; ++bj) { EP_X8(x, acc[ai][bj][m][0], acc[ai][bj][m][1]);
#pragma unroll
                        for (int e = 0; e < 8; ++e) { x[e] = ep_gelu(x[e]); ss += x[e] * x[e]; }
                        *(u32x4*)(VA + (size_t)row * 512 + 256 * (pn - 2) + cw + 32 * bj) = ep_pack8(x); }
                    ss = ep_sum_xor32(ep_sum_xor16(ss));
                    if (fq == 0) SSV[(size_t)row * 8 + (pn - 2) * 4 + wc] = ss; }
        } else if (pn < 16) {
            const bool isk = pn >= 10; const int hd = 4 * (pn - (isk ? 10 : 4)) + wc, g = hd >> 3, hh = hd & 7;
            const float* gq_ = g_q; const float* gk_ = g_k; asm volatile("" : "+s"(gq_), "+s"(gk_));
            const float* gp = (isk ? gk_ : gq_) + 8 * fq;
            const f32x4 ga0 = *(const f32x4*)gp, ga1 = *(const f32x4*)(gp + 4), gb0 = *(const f32x4*)(gp + 32), gb1 = *(const f32x4*)(gp + 36);
            const float gn0[8] = {ga0[0], ga0[1], ga0[2], ga0[3], ga1[0], ga1[1], ga1[2], ga1[3]}, gn1[8] = {gb0[0], gb0[1], gb0[2], gb0[3], gb1[0], gb1[1], gb1[2], gb1[3]};
            bf16_t* dst = (bf16_t*)(ws + (isk ? WS_K : WS_Q));
            { const int t = (wr * 4 + wc) * 64 + fq * 16 + fr, lr = t >> 1, hf = t & 1;
              const float* rt = ROT + (size_t)((u.pm * BM + lr) & 4095) * 16 + hf * 8;
              const f32x4 a0 = *(const f32x4*)rt, a1 = *(const f32x4*)(rt + 4);
              *(PG8_LAS f32x4*)(rott + lr * 16 + hf * 8) = a0; *(PG8_LAS f32x4*)(rott + lr * 16 + hf * 8 + 4) = a1;
              asm volatile("s_waitcnt lgkmcnt(0)" ::: "memory"); __builtin_amdgcn_s_barrier(); }
#pragma unroll
            for (int ai = 0; ai < 2; ++ai)
#pragma unroll
                for (int m = 0; m < 4; ++m) { const int row = row0 + ai * HALF + m * 16;
                    EP_X8(y0, acc[ai][0][m][0], acc[ai][0][m][1]); EP_X8(y1, acc[ai][1][m][0], acc[ai][1][m][1]);
                    float ss = 0.f;
#pragma unroll
                    for (int e = 0; e < 8; ++e) ss += y0[e] * y0[e] + y1[e] * y1[e];
                    ss = ep_sum_xor32(ep_sum_xor16(ss));
                    const float r = __builtin_amdgcn_rsqf(ss * (1.f / 64.f) + 1e-6f);
#pragma unroll
                    for (int e = 0; e < 8; ++e) { y0[e] *= r * gn0[e]; y1[e] *= r * gn1[e]; }
                    const PG8_LAS float* rt = rott + (wr * 64 + fr + ai * HALF + m * 16) * 16;
                    const f32x4 t0 = *(const PG8_LAS f32x4*)rt, t1 = *(const PG8_LAS f32x4*)(rt + 4), t2 = *(const PG8_LAS f32x4*)(rt + 8), t3 = *(const PG8_LAS f32x4*)(rt + 12);
                    const float cs[8] = {t0[0], t0[2], t1[0], t1[2], t2[0], t2[2], t3[0], t3[2]}, sn[8] = {t0[1], t0[3], t1[1], t1[3], t2[1], t2[3], t3[1], t3[3]};
#pragma unroll
                    for (int e = 0; e < 8; ++e) { const float pr = ep_get_xor16(y0[e], (fq & 1) != 0);
                        if (fq == 0) y0[e] = y0[e] * cs[e] - pr * sn[e]; else if (fq == 1) y0[e] = y0[e] * cs[e] + pr * sn[e]; }
                    bf16_t* d = dst + (size_t)ep_perm_row(row, g) * 1536 + hd * 64 + 8 * fq;
                    *(u32x4*)d = ep_pack8(y0); *(u32x4*)(d + 32) = ep_pack8(y1);
                    if (isk) state_out(y0, y1, row, g, hh, 0, fq);
                    asm volatile("" ::: "memory");
                }
        } else if (pn < 22) {
            const int hd = 4 * (pn - 16) + wc, g = hd >> 3, hh = hd & 7;
#pragma unroll
            for (int ai = 0; ai < 2; ++ai)
#pragma unroll
                for (int m = 0; m < 4; ++m) { const int row = row0 + ai * HALF + m * 16;
                    EP_X8(y0, acc[ai][0][m][0], acc[ai][0][m][1]); EP_X8(y1, acc[ai][1][m][0], acc[ai][1][m][1]);
                    bf16_t* d = V + (size_t)ep_perm_row(row, g) * 1536 + hd * 64 + 8 * fq;
                    *(u32x4*)d = ep_pack8(y0); *(u32x4*)(d + 32) = ep_pack8(y1);
                    state_out(y0, y1, row, g, hh, 1, fq);
                    asm volatile("" ::: "memory");
                }
        } else {
            bf16_t* dst = (bf16_t*)(ws + ((pn < 26) ? WS_GA : WS_GB)); const int ct = 256 * ((pn - 22) & 3);
#pragma unroll
            for (int ai = 0; ai < 2; ++ai)
#pragma unroll
                for (int m = 0; m < 4; ++m) { const int row = row0 + ai * HALF + m * 16;
#pragma unroll
                    for (int bj = 0; bj < 2; ++bj) { EP_X8(x, acc[ai][bj][m][0], acc[ai][bj][m][1]);
#pragma unroll
                        for (int e = 0; e < 8; ++e) x[e] = ep_sigmoid(x[e]);
                        *(u32x4*)(dst + (size_t)row * 1024 + ct + cw + 32 * bj) = ep_pack8(x); } }
        }
    }
};

template <int MODE> struct EpiGate {
    static constexpr bool PERM = true, AFTER_DRAIN = false, HEADMAP = false;
    bf16_t* O; const bf16_t* G; const bf16_t* T; int ldc;
    __device__ __forceinline__ void operator()(const f32x4 (&acc)[2][2][4][2], const Unit& u, int wr, int wc, int fr, int fq) const {
        const int row0 = u.pm * BM + wr * 64 + fr, col0 = u.pn * BM + wc * 32 + 8 * fq;
#pragma unroll
        for (int ai = 0; ai < 2; ++ai)
#pragma unroll
            for (int m = 0; m < 4; ++m) { const size_t ro = (size_t)(row0 + ai * HALF + m * 16) * ldc + col0;
#pragma unroll
                for (int bj = 0; bj < 2; ++bj) { EP_X8(x, acc[ai][bj][m][0], acc[ai][bj][m][1]);
                    if (MODE < 2) { float gv[8]; ep_unpack8(*(const u32x4*)(G + ro + bj * HALF), gv);
#pragma unroll
                        for (int e = 0; e < 8; ++e) x[e] *= gv[e]; }
                    if (MODE == 1) { float tv[8]; ep_unpack8(*(const u32x4*)(T + ro + bj * HALF), tv);
#pragma unroll
                        for (int e = 0; e < 8; ++e) x[e] += tv[e]; }
                    *(u32x4*)(O + ro + bj * HALF) = ep_pack8(x); }
                asm volatile("" ::: "memory"); }
    }
};

__device__ __forceinline__ float ep_rstd16(const float* SSQ, int row);
template <bool XIN_BF16> struct EpiResid {
    static constexpr bool PERM = true, AFTER_DRAIN = false, HEADMAP = false;
    const void* xold; bf16_t* XB; float* SSQ; const float* SSQ_IN;
    __device__ __forceinline__ void operator()(const f32x4 (&acc)[2][2][4][2], const Unit& u, int wr, int wc, int fr, int fq) const {
        const int row0 = u.pm * BM + wr * 64 + fr, col0 = u.pn * BM + wc * 32 + 8 * fq;
#pragma unroll
        for (int ai = 0; ai < 2; ++ai)
#pragma unroll
            for (int m = 0; m < 4; ++m) { const int row = row0 + ai * HALF + m * 16; float ss = 0.f; float r2 = 1.f; if (SSQ_IN) { const float r = ep_rstd16(SSQ_IN, row); r2 = r * r; }
#pragma unroll
                for (int bj = 0; bj < 2; ++bj) { EP_X8(x, acc[ai][bj][m][0], acc[ai][bj][m][1]); const size_t o = (size_t)row * 1024 + col0 + bj * HALF;
#pragma unroll
                    for (int e = 0; e < 8; ++e) x[e] *= r2;
                    if (XIN_BF16) { float xo[8]; ep_unpack8(*(const u32x4*)((const bf16_t*)xold + o), xo);
#pragma unroll
                        for (int e = 0; e < 8; ++e) x[e] += xo[e]; }
                    else { const f32x4 a0 = __builtin_nontemporal_load((const f32x4*)((const float*)xold + o)), a1 = __builtin_nontemporal_load((const f32x4*)((const float*)xold + o + 4));
                        x[0] += a0[0]; x[1] += a0[1]; x[2] += a0[2]; x[3] += a0[3]; x[4] += a1[0]; x[5] += a1[1]; x[6] += a1[2]; x[7] += a1[3]; }
#pragma unroll
                    for (int e = 0; e < 8; ++e) ss += x[e] * x[e];
                    *(u32x4*)(XB + o) = ep_pack8(x); }
                ss = ep_sum_xor32(ep_sum_xor16(ss));
                if (fq == 0) SSQ[(size_t)row * 16 + u.pn * 4 + wc] = ss;
                asm volatile("" ::: "memory"); }
    }
};
__device__ __forceinline__ float ep_rstd16(const float* SSQ, int row) {
    const f32x4 s0 = *(const f32x4*)(SSQ + (size_t)row * 16), s1 = *(const f32x4*)(SSQ + (size_t)row * 16 + 4), s2 = *(const f32x4*)(SSQ + (size_t)row * 16 + 8), s3 = *(const f32x4*)(SSQ + (size_t)row * 16 + 12);
    const float ss = (((s0[0] + s0[1]) + (s0[2] + s0[3])) + ((s1[0] + s1[1]) + (s1[2] + s1[3]))) + (((s2[0] + s2[1]) + (s2[2] + s2[3])) + ((s3[0] + s3[1]) + (s3[2] + s3[3])));
    return __builtin_amdgcn_rsqf(ss * (1.f / 1024.f) + 1e-6f);
}
struct EpiFF1 {
    static constexpr bool PERM = true, AFTER_DRAIN = false, HEADMAP = false;
    bf16_t* F; int ldc;
    __device__ __forceinline__ void operator()(const f32x4 (&acc)[2][2][4][2], const Unit& u, int wr, int wc, int fr, int fq) const {
        const int row0 = u.pm * BM + wr * 64 + fr, col0 = u.pn * BM + wc * 32 + 8 * fq;
#pragma unroll
        for (int ai = 0; ai < 2; ++ai)
#pragma unroll
            for (int m = 0; m < 4; ++m) { const int row = row0 + ai * HALF + m * 16;
#pragma unroll
                for (int bj = 0; bj < 2; ++bj) { EP_X8(x, acc[ai][bj][m][0], acc[ai][bj][m][1]);
#pragma unroll
                    for (int e = 0; e < 8; ++e) { const float t = fmaxf(x[e], 0.f); x[e] = t * t; }
                    *(u32x4*)(F + (size_t)row * ldc + col0 + bj * HALF) = ep_pack8(x); }
                asm volatile("" ::: "memory"); }
    }
};
struct EpiFinal {
    static constexpr bool PERM = true, AFTER_DRAIN = false, HEADMAP = false;
    float* y; const bf16_t* X2; const bf16_t* PJ; const float* SSQ;
    __device__ __forceinline__ void operator()(const f32x4 (&acc)[2][2][4][2], const Unit& u, int wr, int wc, int fr, int fq) const {
        const int row0 = u.pm * BM + wr * 64 + fr, col0 = u.pn * BM + wc * 32 + 8 * fq;
#pragma unroll
        for (int ai = 0; ai < 2; ++ai)
#pragma unroll
            for (int m = 0; m < 4; ++m) { const int row = row0 + ai * HALF + m * 16; const float r = ep_rstd16(SSQ, row);
#pragma unroll
                for (int bj = 0; bj < 2; ++bj) { EP_X8(x, acc[ai][bj][m][0], acc[ai][bj][m][1]); const size_t o = (size_t)row * 1024 + col0 + bj * HALF;
                    float pj[8], xo[8]; ep_unpack8(*(const u32x4*)(PJ + o), pj); ep_unpack8(*(const u32x4*)(X2 + o), xo);
#pragma unroll
                    for (int e = 0; e < 8; ++e) x[e] = xo[e] + ep_sigmoid(x[e] * r) * pj[e];
                    __builtin_nontemporal_store((f32x4){x[0], x[1], x[2], x[3]}, (f32x4*)(y + o)); __builtin_nontemporal_store((f32x4){x[4], x[5], x[6], x[7]}, (f32x4*)(y + o + 4)); }
                asm volatile("" ::: "memory"); }
    }
};

constexpr long KVC_TOTAL = 64L * 128 * 1536;
template <int N> struct KvBatch {
    const float* c2; float* out; long lim;
    f32x4 v[N];
    __device__ __forceinline__ bool addr(long i, const f32x4*& s, f32x4*& d) const {
        if (i >= lim) return false;
        const unsigned u = (unsigned)i, seg = u / 196608u, rem = u - seg * 196608u, blk = rem / 1536u, off = rem - blk * 1536u;
        const size_t e = (size_t)seg * (2048 * 128) + (size_t)(16 * blk + 4) * 128 + off;
        s = (const f32x4*)c2 + e; d = (f32x4*)(out + O_KV2048S) + e - 512; return true;
    }
    __device__ __forceinline__ void load(long e0, int tid) {
#pragma unroll
        for (int k = 0; k < N; ++k) { const f32x4* s; f32x4* d; if (addr(e0 + 512 * k + tid, s, d)) v[k] = __builtin_nontemporal_load(s); }
    }
    __device__ __forceinline__ void store(long e0, int tid) {
        asm volatile("" : "+v"(tid));
#pragma unroll
        for (int k = 0; k < N; ++k) { const f32x4* s; f32x4* d; if (addr(e0 + 512 * k + tid, s, d)) __builtin_nontemporal_store(v[k], d); }
    }
};
constexpr int KVC_BN = 14, KVC_GN = 0;
constexpr long KVC_E_GEMM = KVC_TOTAL - 4480L * 512 * KVC_GN;
static_assert(KVC_E_GEMM >= 0 && 8L * 256 * 448 * KVC_BN >= KVC_E_GEMM, "the copy does not fit its hosts");
struct KvCopy {
    KvBatch<KVC_GN> b; int base;
    __device__ __forceinline__ void load(const Unit& u, int tid) { b.load(KVC_E_GEMM + (long)(base + u.L) * (512 * KVC_GN), tid); }
    __device__ __forceinline__ void store(const Unit& u, int tid) { b.store(KVC_E_GEMM + (long)(base + u.L) * (512 * KVC_GN), tid); }
};

struct NoCopy { __device__ __forceinline__ void load(const Unit&, int) {} __device__ __forceinline__ void store(const Unit&, int) {} };
template <class Epi, class Sched, bool ALIGN_EPI = false, bool SP2 = false, class CP = NoCopy>
__device__ __forceinline__ void gemm_phase(PG8_LAS unsigned char* lds, const Gemm g, const Sched& S, const Epi& E, CP cp = CP()) {
    int tid_ = threadIdx.x; asm volatile("" : "+v"(tid_));
    const int tid = tid_, wid = __builtin_amdgcn_readfirstlane(tid >> 6), lane = tid & 63, wr = wid >> 2, wc = wid & 3, fr = lane & 15, fq = lane >> 4;
    const int K = g.K, nt = K / BK;
    unsigned voffA[2], voffB[2];
#pragma unroll
    for (int i = 0; i < 2; ++i) { int R, C; stage_rc(tid * 16 + i * 8192, R, C); const int Rb = Epi::HEADMAP ? (64 * (R >> 5) + perm32(R & 31)) : (Epi::PERM ? ((R & ~31) + perm32(R & 31)) : R);
        voffA[i] = (unsigned)(R * K + C) * 2u; voffB[i] = (unsigned)(Rb * K + C) * 2u; }
    const size_t kstep = (size_t)(BK * 2);
    const size_t hstep = (size_t)HALF * K * 2;
    const size_t tstep = 2 * hstep;
    const size_t hstepB = Epi::HEADMAP ? (size_t)32 * K * 2 : hstep;
    const unsigned ldsw = (unsigned)wid * 1024u;
    const int aoff = lds_byte(wr * 64 + fr, fq * 8), boff = lds_byte(wc * 32 + fr, fq * 8);
#define PG8_SA(b, h) (((b) * 2 + (h)) * HTB)
#define PG8_SB(b, h) ((4 + (b) * 2 + (h)) * HTB)
#define PG8_STAGE(bufoff, gbase, voff) do { _Pragma("unroll") for (int _i = 0; _i < 2; ++_i) \
        __builtin_amdgcn_global_load_lds((const unsigned*)((const char*)(gbase) + (voff)[_i]), (PG8_LAS unsigned*)(lds + (bufoff) + ldsw + _i * 8192), 16, 0, 0); } while (0)
#define PG8_LDA(dst, b, h) do { _Pragma("unroll") for (int m = 0; m < 4; ++m) _Pragma("unroll") for (int k = 0; k < 2; ++k) dst[m][k] = *(const PG8_LAS bf16x8*)(lds + PG8_SA(b, h) + aoff + m * 2048 + k * 1024); } while (0)
#define PG8_LDB(dst, b, h) do { _Pragma("unroll") for (int n = 0; n < 2; ++n) _Pragma("unroll") for (int k = 0; k < 2; ++k) dst[n][k] = *(const PG8_LAS bf16x8*)(lds + PG8_SB(b, h) + boff + n * 2048 + k * 1024); } while (0)
#define PG8_MMA(ai, bj, At, Bt) do { __builtin_amdgcn_s_setprio(1); _Pragma("unroll") for (int m = 0; m < 4; ++m) _Pragma("unroll") for (int n = 0; n < 2; ++n) _Pragma("unroll") for (int k = 0; k < 2; ++k) \
        acc[ai][bj][m][n] = __builtin_amdgcn_mfma_f32_16x16x32_bf16(Bt[n][k], At[m][k], acc[ai][bj][m][n], 0, 0, 0); __builtin_amdgcn_s_setprio(0); } while (0)
#define PG8_WAIT_V(n) asm volatile("s_waitcnt vmcnt(" #n ")" ::: "memory")
#define PG8_WAIT_L(n) asm volatile("s_waitcnt lgkmcnt(" #n ")" ::: "memory")
#define PG8_BAR __builtin_amdgcn_s_barrier()
#define PG8_SCHED __builtin_amdgcn_sched_barrier(0)
    Unit cur, nxt; int ui = 0;
    if (!S.next(0, cur)) return;
    f32x4 acc[2][2][4][2];
#pragma unroll
    for (int a = 0; a < 2; ++a)
#pragma unroll
        for (int b = 0; b < 2; ++b)
#pragma unroll
            for (int m = 0; m < 4; ++m)
#pragma unroll
                for (int n = 0; n < 2; ++n) acc[a][b][m][n] = (f32x4){0.f, 0.f, 0.f, 0.f};
    bf16x8 At[4][2], B0[2][2], B1[2][2];
    const char* cA = (const char*)g.A + (size_t)cur.pm * tstep; const char* cB = (const char*)g.Bt + (size_t)cur.pn * tstep;
    S.a_ready(cur);
    if constexpr (SP2) {
        PG8_STAGE(PG8_SB(0, 0), cB, voffB); PG8_STAGE(PG8_SB(0, 1), cB + hstepB, voffB); PG8_STAGE(PG8_SA(0, 0), cA, voffA); PG8_STAGE(PG8_SA(0, 1), cA + hstep, voffA);
        if (wr == 1) PG8_BAR;
        PG8_WAIT_V(2); PG8_BAR;
        PG8_STAGE(PG8_SB(1, 0), cB + kstep, voffB); PG8_STAGE(PG8_SA(1, 0), cA + kstep, voffA); PG8_STAGE(PG8_SB(1, 1), cB + hstepB + kstep, voffB);
        PG8_WAIT_V(6); PG8_BAR;
    } else {
        PG8_STAGE(PG8_SB(0, 0), cB, voffB); PG8_STAGE(PG8_SA(0, 0), cA, voffA); PG8_STAGE(PG8_SB(0, 1), cB + hstepB, voffB); PG8_STAGE(PG8_SA(0, 1), cA + hstep, voffA);
        if (wr == 1) PG8_BAR;
        PG8_WAIT_V(4); PG8_BAR;
        PG8_STAGE(PG8_SB(1, 0), cB + kstep, voffB); PG8_STAGE(PG8_SA(1, 0), cA + kstep, voffA); PG8_STAGE(PG8_SB(1, 1), cB + hstepB + kstep, voffB);
        PG8_WAIT_V(6); PG8_BAR;
    }
    for (;;) {
        const bool has_next = S.next(ui + 1, nxt);
        const char* nA = has_next ? (const char*)g.A + (size_t)nxt.pm * tstep : cA; const char* nB = has_next ? (const char*)g.Bt + (size_t)nxt.pn * tstep : cB;
#pragma unroll 1
        for (int t = 0; t < nt; t += 2) {
            const bool last = (t == nt - 2);
            const char* a1 = cA + (size_t)(t + 1) * kstep;
            const char* a2 = last ? nA : cA + (size_t)(t + 2) * kstep; const char* b2 = last ? nB : cB + (size_t)(t + 2) * kstep;
            const char* a3 = a2 + kstep; const char* b3 = b2 + kstep;
            if (last && has_next) S.a_ready(nxt);
            if constexpr (SP2) {
            PG8_LDB(B0, 0, 0); PG8_LDB(B1, 0, 1); PG8_SCHED; PG8_LDA(At, 0, 0); PG8_STAGE(PG8_SA(1, 1), a1 + hstep, voffA);
            PG8_WAIT_V(8); PG8_WAIT_L(0); PG8_BAR; PG8_MMA(0, 0, At, B0); PG8_MMA(0, 1, At, B1); PG8_BAR; PG8_SCHED;
            PG8_LDA(At, 0, 1); PG8_STAGE(PG8_SB(0, 0), b2, voffB); PG8_STAGE(PG8_SB(0, 1), b2 + hstepB, voffB); PG8_STAGE(PG8_SA(0, 0), a2, voffA);
            PG8_WAIT_V(8); PG8_WAIT_L(0); PG8_BAR; PG8_MMA(1, 0, At, B0); PG8_MMA(1, 1, At, B1); PG8_BAR; PG8_SCHED;
            PG8_LDB(B0, 1, 0); PG8_LDB(B1, 1, 1); PG8_SCHED; PG8_LDA(At, 1, 0); PG8_STAGE(PG8_SA(0, 1), a2 + hstep, voffA);
            PG8_WAIT_V(8); PG8_WAIT_L(0); PG8_BAR; PG8_MMA(0, 0, At, B0); PG8_MMA(0, 1, At, B1); PG8_BAR; PG8_SCHED;
            PG8_LDA(At, 1, 1); PG8_STAGE(PG8_SB(1, 0), b3, voffB); PG8_STAGE(PG8_SB(1, 1), b3 + hstepB, voffB); PG8_STAGE(PG8_SA(1, 0), a3, voffA);
            PG8_WAIT_V(8); PG8_WAIT_L(0); PG8_BAR; PG8_MMA(1, 0, At, B0); PG8_MMA(1, 1, At, B1); PG8_BAR; PG8_SCHED;
            } else {
            PG8_LDB(B0, 0, 0); PG8_SCHED; PG8_LDA(At, 0, 0); PG8_STAGE(PG8_SA(1, 1), a1 + hstep, voffA);
            PG8_WAIT_L(8); PG8_BAR; PG8_WAIT_L(0); PG8_MMA(0, 0, At, B0); PG8_BAR; PG8_SCHED;
            PG8_LDB(B1, 0, 1); PG8_STAGE(PG8_SB(0, 0), b2, voffB);
            PG8_BAR; PG8_WAIT_L(0); PG8_MMA(0, 1, At, B1); PG8_BAR;
            PG8_LDA(At, 0, 1); PG8_STAGE(PG8_SA(0, 0), a2, voffA);
            PG8_BAR; PG8_WAIT_L(0); PG8_MMA(1, 0, At, B0); PG8_BAR; PG8_SCHED;
            PG8_STAGE(PG8_SB(0, 1), b2 + hstepB, voffB);
            PG8_WAIT_V(6); PG8_BAR; PG8_MMA(1, 1, At, B1); PG8_BAR;
            PG8_LDB(B0, 1, 0); PG8_SCHED; PG8_LDA(At, 1, 0); PG8_STAGE(PG8_SA(0, 1), a2 + hstep, voffA);
            PG8_WAIT_L(8); PG8_BAR; PG8_WAIT_L(0); PG8_MMA(0, 0, At, B0); PG8_BAR; PG8_SCHED;
            PG8_LDB(B1, 1, 1); PG8_STAGE(PG8_SB(1, 0), b3, voffB);
            PG8_BAR; PG8_WAIT_L(0); PG8_MMA(0, 1, At, B1); PG8_BAR;
            PG8_LDA(At, 1, 1); PG8_STAGE(PG8_SA(1, 0), a3, voffA);
            PG8_BAR; PG8_WAIT_L(0); PG8_MMA(1, 0, At, B0); PG8_BAR; PG8_SCHED;
            PG8_STAGE(PG8_SB(1, 1), b3 + hstepB, voffB);
            PG8_WAIT_V(6); PG8_BAR; PG8_MMA(1, 1, At, B1); PG8_BAR;
            }
        }
        if constexpr (ALIGN_EPI) { if (wr == 0) PG8_BAR; }
        if constexpr (!Epi::AFTER_DRAIN) { cp.load(cur, tid); E(acc, cur, wr, wc, fr, fq); cp.store(cur, tid); S.done(cur); }
        if (!has_next) break;
#pragma unroll
        for (int a = 0; a < 2; ++a)
#pragma unroll
            for (int b = 0; b < 2; ++b)
#pragma unroll
                for (int m = 0; m < 4; ++m)
#pragma unroll
                    for (int n = 0; n < 2; ++n) acc[a][b][m][n] = (f32x4){0.f, 0.f, 0.f, 0.f};
        cur = nxt; cA = nA; cB = nB; ++ui;
        if constexpr (ALIGN_EPI) { if (wr == 1) PG8_BAR; }
    }
    PG8_WAIT_V(0);
    if constexpr (!ALIGN_EPI) { if (wr == 0) PG8_BAR; }
    PG8_BAR;
    if constexpr (Epi::AFTER_DRAIN) { E.fused(acc, cur, wr, wc, fr, fq, lds, wid, lane); S.done(cur); }
#undef PG8_SA
#undef PG8_SB
#undef PG8_STAGE
#undef PG8_LDA
#undef PG8_LDB
#undef PG8_MMA
#undef PG8_WAIT_V
#undef PG8_WAIT_L
#undef PG8_BAR
#undef PG8_SCHED
}
}
namespace sg {
typedef short bf16x8 __attribute__((ext_vector_type(8)));
typedef float f32x4 __attribute__((ext_vector_type(4)));
typedef unsigned u32x2 __attribute__((ext_vector_type(2)));
typedef unsigned u32x4 __attribute__((ext_vector_type(4)));
typedef __bf16 bf16x2 __attribute__((ext_vector_type(2)));
typedef float f32x2 __attribute__((ext_vector_type(2)));
__device__ __forceinline__ unsigned cvt2(float lo, float hi) { f32x2 v = {lo, hi}; bf16x2 b = __builtin_convertvector(v, bf16x2); return __builtin_bit_cast(unsigned, b); }
__device__ __forceinline__ float blo(unsigned w) { return __builtin_bit_cast(float, w << 16); }
__device__ __forceinline__ float bhi(unsigned w) { return __builtin_bit_cast(float, w & 0xffff0000u); }
__device__ __forceinline__ float sigm(float x) { return __builtin_amdgcn_rcpf(1.0f + __builtin_amdgcn_exp2f(-1.4426950408889634f * x)); }
__device__ __forceinline__ float gelu(float x) { const float y = 0.7978845608028654f * (x + 0.044715f * x * x * x); return x * sigm(2.0f * y); }

template <int NT, bool AF32, int UN = 4>
__device__ __forceinline__ void core(f32x4 (&acc)[NT], float& ss, const void* A, int lda, int row, const unsigned short* Wt, int ldw, int col0, int k0, int klen, int lane) {
    const int tok = lane & 15, fq = lane >> 4;
    const unsigned short* wp = Wt + (size_t)(col0 + tok) * ldw + k0 + 8 * fq;
    const unsigned short* a16 = (const unsigned short*)A + (size_t)row * lda + k0 + 8 * fq;
    const float* a32 = (const float*)A + (size_t)row * lda + k0 + 8 * fq;
#pragma unroll UN
    for (int k = 0; k < klen; k += 32) {
        bf16x8 af;
        if (AF32) { const f32x4 x0 = *(const f32x4*)(a32 + k), x1 = *(const f32x4*)(a32 + k + 4);
            ss += (x0[0] * x0[0] + x0[1] * x0[1]) + (x0[2] * x0[2] + x0[3] * x0[3]) + (x1[0] * x1[0] + x1[1] * x1[1]) + (x1[2] * x1[2] + x1[3] * x1[3]);
            af = __builtin_bit_cast(bf16x8, (u32x4){cvt2(x0[0], x0[1]), cvt2(x0[2], x0[3]), cvt2(x1[0], x1[1]), cvt2(x1[2], x1[3])}); }
        else af = *(const bf16x8*)(a16 + k);
#pragma unroll
        for (int nt = 0; nt < NT; ++nt) { const bf16x8 bf = *(const bf16x8*)(wp + (size_t)(16 * nt) * ldw + k);
            acc[nt] = __builtin_amdgcn_mfma_f32_16x16x32_bf16(bf, af, acc[nt], 0, 0, 0); }
    }
}
template <bool AF32, int STEPS>
__device__ __forceinline__ void core8(f32x4& out, float& ssout, __attribute__((address_space(3))) float* red, const void* A, int lda, int row0, const unsigned short* Wt, int ldw, int col0, int k0, int lane, int w) {
    const int tok = lane & 15, fq = lane >> 4, kw = k0 + 32 * STEPS * w + 8 * fq;
    bf16x8 af[2][STEPS], bfr[4][STEPS]; float ss[2] = {0.f, 0.f};
    if (AF32) {
        f32x4 x[2][STEPS][2];
#pragma unroll
        for (int rt = 0; rt < 2; ++rt)
#pragma unroll
            for (int s = 0; s < STEPS; ++s) { const float* p = (const float*)A + (size_t)(row0 + 16 * rt + tok) * lda + kw + 32 * s; x[rt][s][0] = *(const f32x4*)p; x[rt][s][1] = *(const f32x4*)(p + 4); }
#pragma unroll
        for (int ct = 0; ct < 4; ++ct)
#pragma unroll
            for (int s = 0; s < STEPS; ++s) bfr[ct][s] = *(const bf16x8*)(Wt + (size_t)(col0 + 16 * ct + tok) * ldw + kw + 32 * s);
#pragma unroll
        for (int rt = 0; rt < 2; ++rt)
#pragma unroll
            for (int s = 0; s < STEPS; ++s) { const f32x4 x0 = x[rt][s][0], x1 = x[rt][s][1];
                ss[rt] += (x0[0] * x0[0] + x0[1] * x0[1]) + (x0[2] * x0[2] + x0[3] * x0[3]) + (x1[0] * x1[0] + x1[1] * x1[1]) + (x1[2] * x1[2] + x1[3] * x1[3]);
                af[rt][s] = __builtin_bit_cast(bf16x8, (u32x4){cvt2(x0[0], x0[1]), cvt2(x0[2], x0[3]), cvt2(x1[0], x1[1]), cvt2(x1[2], x1[3])}); }
    } else {
#pragma unroll
        for (int rt = 0; rt < 2; ++rt)
#pragma unroll
            for (int s = 0; s < STEPS; ++s) af[rt][s] = *(const bf16x8*)((const unsigned short*)A + (size_t)(row0 + 16 * rt + tok) * lda + kw + 32 * s);
#pragma unroll
        for (int ct = 0; ct < 4; ++ct)
#pragma unroll
            for (int s = 0; s < STEPS; ++s) bfr[ct][s] = *(const bf16x8*)(Wt + (size_t)(col0 + 16 * ct + tok) * ldw + kw + 32 * s);
    }
#pragma unroll
    for (int rt = 0; rt < 2; ++rt)
#pragma unroll
        for (int ct = 0; ct < 4; ++ct) { f32x4 acc = (f32x4){0.f, 0.f, 0.f, 0.f};
#pragma unroll
            for (int s = 0; s < STEPS; ++s) acc = __builtin_amdgcn_mfma_f32_16x16x32_bf16(bfr[ct][s], af[rt][s], acc, 0, 0, 0);
            *(__attribute__((address_space(3))) f32x4*)(red + ((w * 8 + rt * 4 + ct) * 64 + lane) * 4) = acc; }
    if (AF32) {
#pragma unroll
        for (int rt = 0; rt < 2; ++rt) { float v = ss[rt]; v += __shfl_xor(v, 16); v += __shfl_xor(v, 32); if (fq == 0) red[16384 + w * 32 + rt * 16 + tok] = v; }
    }
    __syncthreads();
    f32x4 o = (f32x4){0.f, 0.f, 0.f, 0.f}; float so = 0.f;
#pragma unroll
    for (int w2 = 0; w2 < 8; ++w2) { o += *(const __attribute__((address_space(3))) f32x4*)(red + ((w2 * 8 + w) * 64 + lane) * 4); if (AF32) so += red[16384 + w2 * 32 + (w >> 2) * 16 + tok]; }
    out = o; ssout = so;
    __syncthreads();
}
}


#define GAS __attribute__((address_space(1)))
#define LAS __attribute__((address_space(3)))
typedef unsigned short bf16;
typedef unsigned v4u __attribute__((ext_vector_type(4)));
typedef unsigned v2u __attribute__((ext_vector_type(2)));
typedef float f32x4 __attribute__((ext_vector_type(4)));
#define LDS_WAIT() asm volatile("s_waitcnt lgkmcnt(0)" ::: "memory")
#define VM_WAIT() asm volatile("s_waitcnt vmcnt(0)" ::: "memory")
__device__ __forceinline__ unsigned f2bf(float f) { unsigned u = __builtin_bit_cast(unsigned, f); return (u + 0x7fffu + ((u >> 16) & 1u)) >> 16; }
__device__ __forceinline__ unsigned pk2(float lo, float hi) { return f2bf(lo) | (f2bf(hi) << 16); }
__device__ __forceinline__ float bf2f(unsigned short b) { return __builtin_bit_cast(float, (unsigned)b << 16); }
__device__ __forceinline__ float bflo(unsigned w) { return __builtin_bit_cast(float, w << 16); }
__device__ __forceinline__ float bfhi(unsigned w) { return __builtin_bit_cast(float, w & 0xffff0000u); }

#define XB_TMO      128
#define XB_XCNT(j)  (256  + 64 * (j))
#define XB_XSUB(j)  (1280 + 64 * (j))
#define XB_XGEN(j)  (2304 + 64 * (j))
#define XB_TOP      3328
#define XB_TOPGEN   3392
#define XCD_BAR_WORDS 3456
#define XB_SPIN_CAP (1u << 18)

__device__ __forceinline__ unsigned xb_ld(unsigned* p)              { return __hip_atomic_load(p, __ATOMIC_RELAXED, __HIP_MEMORY_SCOPE_AGENT); }
__device__ __forceinline__ unsigned xb_add(unsigned* p, unsigned v) { return __hip_atomic_fetch_add(p, v, __ATOMIC_RELAXED, __HIP_MEMORY_SCOPE_AGENT); }
__device__ __forceinline__ unsigned xb_xcc_id() { return (unsigned)__builtin_amdgcn_s_getreg((3 << 11) | 20) & 0xFu; }
#define XB_SPIN(cond, bar) do { unsigned _sp = 0; while (cond) { __builtin_amdgcn_s_sleep(1); \
    if ((++_sp & 255u) == 0u) { if (xb_ld(&(bar)[XB_TMO])) break; if (_sp > XB_SPIN_CAP) { atomicAdd(&(bar)[XB_TMO], 1u); break; } } } } while (0)

struct XcdBarrier {
    unsigned* bar; unsigned x;
    volatile LAS unsigned* st;
};

__device__ __forceinline__ XcdBarrier xcd_barrier_post(unsigned* bar, volatile LAS unsigned* st) {
    XcdBarrier b; b.bar = bar; b.x = xb_xcc_id(); b.st = st;
    if (threadIdx.x == 0) (void)xb_add(&bar[XB_XCNT(b.x)], 1u);
    return b;
}
__device__ __forceinline__ void xcd_barrier_complete(unsigned* bar, unsigned x, unsigned& nloc, unsigned& nx) {
    const unsigned G = gridDim.x * gridDim.y * gridDim.z;
    unsigned sum, cnt, mine, sp = 0u;
    for (;;) {
        sum = 0u; cnt = 0u; mine = 0u;
#pragma unroll
        for (unsigned j = 0; j < 16; ++j) { const unsigned c = xb_ld(&bar[XB_XCNT(j)]); sum += c; cnt += (c > 0u) ? 1u : 0u; mine = (j == x) ? c : mine; }
        if (sum == G) break;
        __builtin_amdgcn_s_sleep(1);
        if ((++sp & 255u) == 0u) { if (xb_ld(&bar[XB_TMO])) break; if (sp > XB_SPIN_CAP) { atomicAdd(&bar[XB_TMO], 1u); break; } }
    }
    nloc = mine > 0u ? mine : 1u; nx = cnt > 0u ? cnt : 1u;
}

template <int BN> __device__ __forceinline__ void xcd_barrier(const XcdBarrier& b, const float* kvc, float* kvo, long e0) {
    pg8::KvBatch<BN> kb{kvc, kvo, pg8::KVC_E_GEMM, {}}; const long eb = e0 + (long)threadIdx.x - 64;
    asm volatile("s_waitcnt vmcnt(0)" ::: "memory");
    __syncthreads();
    if (threadIdx.x >= 64) {
#pragma unroll
        for (int k = 0; k < BN; ++k) { const f32x4* sp; f32x4* dp; if (kb.addr(eb + 448 * k, sp, dp)) kb.v[k] = __builtin_nontemporal_load(sp); }
#pragma unroll
        for (int k = 0; k < BN; ++k) { const f32x4* sp; f32x4* dp; if (kb.addr(eb + 448 * k, sp, dp)) __builtin_nontemporal_store(kb.v[k], dp); }
    }
    if (threadIdx.x == 0) {
        unsigned* bar = b.bar;
        __builtin_amdgcn_s_waitcnt(0);
        unsigned nloc = b.st[0], nx = b.st[1];
        if (nloc == 0u) { xcd_barrier_complete(bar, b.x, nloc, nx); b.st[0] = nloc; b.st[1] = nx; }
        const unsigned old = xb_add(&bar[XB_XSUB(b.x)], 1u);
        const unsigned gen = old / nloc;
        if (old + 1u == (gen + 1u) * nloc) {
            __builtin_amdgcn_fence(__ATOMIC_RELEASE, "agent");
            asm volatile("s_waitcnt vmcnt(0)" ::: "memory");
            const unsigned og = xb_add(&bar[XB_TOP], 1u);
            const unsigned tg = og / nx;
            if (og + 1u == (tg + 1u) * nx) xb_add(&bar[XB_TOPGEN], 1u);
            else XB_SPIN(xb_ld(&bar[XB_TOPGEN]) == tg, bar);
            __builtin_amdgcn_fence(__ATOMIC_ACQUIRE, "agent");
            xb_add(&bar[XB_XGEN(b.x)], 1u);
            asm volatile("s_waitcnt vmcnt(0)" ::: "memory");
        } else {
            XB_SPIN(xb_ld(&bar[XB_XGEN(b.x)]) == gen, bar);
            __builtin_amdgcn_fence(__ATOMIC_ACQUIRE, "agent");
            asm volatile("s_waitcnt vmcnt(0)" ::: "memory");
        }
    }
    __syncthreads();
}

__device__ __forceinline__ float wave_sum(float v) {
#pragma unroll
    for (int o = 1; o < 64; o <<= 1) v += __shfl_xor(v, o);
    return v;
}
__device__ __forceinline__ float wave_max(float v) {
#pragma unroll
    for (int o = 1; o < 64; o <<= 1) v = fmaxf(v, __shfl_xor(v, o));
    return v;
}
__device__ __forceinline__ float sigmoidf_(float x) { return __builtin_amdgcn_rcpf(1.0f + __builtin_amdgcn_exp2f(-1.4426950408889634f * x)); }
__device__ __forceinline__ float gelu_tanh(float x) { const float y = 0.7978845608028654f * (x + 0.044715f * x * x * x); return x * sigmoidf_(2.0f * y); }

struct P0Item { const float* W; bf16* WT; const float* gk; int K, N; };
__device__ __forceinline__ void p0_item_load(const P0Item d, int item, int lane, f32x4 (&w)[8], float (&g)[8]) {
    const int nblk = d.N / 32, kb = item / nblk, nb = item % nblk, k0 = 64 * kb, n0 = 32 * nb, r8 = lane >> 3, c4 = lane & 7;
#pragma unroll
    for (int i = 0; i < 8; ++i) { const int kk = 8 * i + r8; w[i] = __builtin_nontemporal_load((const GAS f32x4*)(d.W + (size_t)(k0 + kk) * d.N + n0) + c4); g[i] = d.gk ? d.gk[k0 + kk] : 1.0f; }
}
__device__ __forceinline__ void p0_item_finish(const P0Item d, int item, int lane, LAS float* scr, const f32x4 (&w)[8], const float (&g)[8]) {
    const int nblk = d.N / 32, kb = item / nblk, nb = item % nblk, k0 = 64 * kb, n0 = 32 * nb, r8 = lane >> 3, c4 = lane & 7;
#pragma unroll
    for (int i = 0; i < 8; ++i) { LAS float* dd = scr + (8 * i + r8) * 33 + 4 * c4; dd[0] = w[i].x * g[i]; dd[1] = w[i].y * g[i]; dd[2] = w[i].z * g[i]; dd[3] = w[i].w * g[i]; }
    LDS_WAIT(); asm volatile("" ::: "memory");
    const int c = lane & 7;
#pragma unroll
    for (int j = 0; j < 4; ++j) { const int n = (lane >> 3) + 8 * j; const LAS float* sp = scr + (8 * c) * 33 + n;
        v4u o; o.x = pk2(sp[0 * 33], sp[1 * 33]); o.y = pk2(sp[2 * 33], sp[3 * 33]); o.z = pk2(sp[4 * 33], sp[5 * 33]); o.w = pk2(sp[6 * 33], sp[7 * 33]);
        *(GAS v4u*)(d.WT + (size_t)(n0 + n) * d.K + k0 + 8 * c) = o; }
    LDS_WAIT(); asm volatile("" ::: "memory");
}

struct Frame {
    LAS unsigned char* lds;
    int tid, lane, wave, vcu, G;
};

struct Args { const float* in[23]; float* out; unsigned char* ws; };

__device__ __forceinline__ void rot_cs(int pos, int i, float& c, float& s) {
    const float inv = exp2f(-(float)i * (18.931568569324174f / 8.0f));
    const float ang = (float)pos * inv;
    const double rev = (double)ang * 0.15915494309189535;
    const float fr = (float)(rev - floor(rev));
    s = __builtin_amdgcn_sinf(fr); c = __builtin_amdgcn_cosf(fr);
}

__device__ __forceinline__ void p0_prologue(const Frame& F, const Args& a) {
    unsigned char* ws = a.ws;
    LAS float* scr = (LAS float*)(F.lds + RING_OFF + F.wave * 16384);
    const int gw = F.vcu * NWAVES + F.wave, NGW = F.G * NWAVES;
    const int e0 = blockIdx.x * 512 + F.tid;
    float wsv = 0.f; f32x4 xsv = (f32x4){0.f, 0.f, 0.f, 0.f};
    if (e0 < 4 * 128 * 128) wsv = a.in[10][e0];
    if (e0 < M_SAMPLE * D / 4) xsv = ((const GAS f32x4*)a.in[1])[e0];
    {
        float* ROT = (float*)(ws + WS_ROT);
        for (int i = e0; i < 4100 * 8; i += F.G * 512) { const int idx = i >> 3, pos = idx < 4096 ? idx : PAST_LEN + (idx - 4096); float c, sn; rot_cs(pos, i & 7, c, sn); ROT[2 * i] = c; ROT[2 * i + 1] = sn; }
        float* MGS = (float*)(ws + WS_MGS);
        for (int i = e0; i < M_SAMPLE * D / 4; i += F.G * 512) ((GAS f32x4*)MGS)[i] = (f32x4){0.f, 0.f, 0.f, 0.f};
    }
    {
        constexpr int I_IN = (D / 64) * (D_IN / 32), I_OA = (D_A / 64) * (D / 32), I_OB = I_OA, I_O = (D / 64) * (D / 32), I_F1 = (D / 64) * (D_FF / 32), I_F2 = (D_FF / 64) * (D / 32), I_PG = I_O, I_PP = (D_PLE / 64) * (D / 32);
        constexpr int NITEMS = I_IN + I_OA + I_OB + I_O + I_F1 + I_F2 + I_PG + I_PP;
        const float* gm = a.in[7];
        bf16* H = (bf16*)(ws + WS_H); bf16* PE = (bf16*)(ws + WS_PE);
        int it = gw, m0 = gw;
        auto DESC = [&](int r, P0Item& d) -> int {
            if (r < I_IN) { d = P0Item{a.in[8], (bf16*)(ws + WS_WIN), nullptr, D, D_IN}; return r; }
            if ((r -= I_IN) < I_OA) { d = P0Item{a.in[14], (bf16*)(ws + WS_WOA), nullptr, D_A, D}; return r; }
            if ((r -= I_OA) < I_OB) { d = P0Item{a.in[15], (bf16*)(ws + WS_WOB), nullptr, D_A, D}; return r; }
            if ((r -= I_OB) < I_O) { d = P0Item{a.in[16], (bf16*)(ws + WS_WO), nullptr, D, D}; return r; }
            if ((r -= I_O) < I_F1) { d = P0Item{a.in[18], (bf16*)(ws + WS_WFF1), a.in[17], D, D_FF}; return r; }
            if ((r -= I_F1) < I_F2) { d = P0Item{a.in[19], (bf16*)(ws + WS_WFF2), nullptr, D_FF, D}; return r; }
            if ((r -= I_F2) < I_PG) { d = P0Item{a.in[21], (bf16*)(ws + WS_WPG), a.in[20], D, D}; return r; }
            r -= I_PG; d = P0Item{a.in[22], (bf16*)(ws + WS_WPP), nullptr, D_PLE, D}; return r;
        };
        f32x4 wq[8]; float gq[8]; P0Item dc{nullptr, nullptr, nullptr, 0, 0}; int rc = 0;
        if (it < NITEMS) { rc = DESC(it, dc); p0_item_load(dc, rc, F.lane, wq, gq); }
        while (it < NITEMS || m0 < MV) {
            const bool rows = m0 < MV;
            const int m1 = (m0 + NGW < MV) ? m0 + NGW : m0;
            f32x4 v[2][4], p[2];
            if (rows) {
#pragma unroll
                for (int q = 0; q < 2; ++q) { const int m = q ? m1 : m0;
                    const float* xrow = (m < M_PROMPT) ? a.in[0] + (size_t)m * D : a.in[1] + (size_t)(m - M_PROMPT) * D;
                    const float* prow = (m < M_PROMPT) ? a.in[2] + (size_t)m * D_PLE : a.in[3] + (size_t)(m - M_PROMPT) * D_PLE;
#pragma unroll
                    for (int j = 0; j < 4; ++j) v[q][j] = __builtin_nontemporal_load((const GAS f32x4*)xrow + F.lane + 64 * j);
                    p[q] = __builtin_nontemporal_load((const GAS f32x4*)prow + F.lane); }
            }
            if (it < NITEMS) {
                f32x4 wc_[8]; float gc_[8];
#pragma unroll
                for (int i = 0; i < 8; ++i) { wc_[i] = wq[i]; gc_[i] = gq[i]; }
                const P0Item dn = dc; const int rn = rc;
                if (it + NGW < NITEMS) { rc = DESC(it + NGW, dc); p0_item_load(dc, rc, F.lane, wq, gq); }
                p0_item_finish(dn, rn, F.lane, scr, wc_, gc_);
                it += NGW;
            }
            if (rows) {
#pragma unroll
                for (int q = 0; q < 2; ++q) { const int m = q ? m1 : m0; float s = 0.f;
#pragma unroll
                    for (int j = 0; j < 4; ++j) s += (v[q][j].x * v[q][j].x + v[q][j].y * v[q][j].y) + (v[q][j].z * v[q][j].z + v[q][j].w * v[q][j].w);
                    const float r = __builtin_amdgcn_rsqf(wave_sum(s) * (1.f / D) + EPS);
                    GAS unsigned long long* o8 = (GAS unsigned long long*)(H + (size_t)m * D) + F.lane;
#pragma unroll
                    for (int j = 0; j < 4; ++j) { const f32x4 g = ((const GAS f32x4*)gm)[F.lane + 64 * j];
                        o8[64 * j] = (unsigned long long)pk2(v[q][j].x * r * g.x, v[q][j].y * r * g.y) | ((unsigned long long)pk2(v[q][j].z * r * g.z, v[q][j].w * r * g.w) << 32); }
                    ((GAS unsigned long long*)(PE + (size_t)m * D_PLE))[F.lane] = (unsigned long long)pk2(p[q].x, p[q].y) | ((unsigned long long)pk2(p[q].z, p[q].w) << 32); }
                m0 += 2 * NGW;
            }
        }
    }
    {
        const float* w_s = a.in[10]; bf16* WSB = (bf16*)(ws + WS_WSB);
        if (e0 < 4 * 128 * 128) { const int t = (e0 >> 7) & 127, sx = e0 & 127; WSB[e0] = (bf16)f2bf(sx <= t ? wsv : 0.f); }
        for (int i = e0 + F.G * 512; i < 4 * 128 * 128; i += F.G * 512) { const int t = (i >> 7) & 127, sx = i & 127; WSB[i] = (bf16)f2bf(sx <= t ? w_s[i] : 0.f); }
        float* X1S = (float*)(ws + WS_X1S); const float* xs = a.in[1];
        if (e0 < M_SAMPLE * D / 4) ((GAS f32x4*)X1S)[e0] = xsv;
        for (int i = e0 + F.G * 512; i < M_SAMPLE * D / 4; i += F.G * 512) ((GAS f32x4*)X1S)[i] = ((const GAS f32x4*)xs)[i];
    }
}

__device__ __forceinline__ int perm_row(int m, int g) {
    if (g == 0 || m >= M_PROMPT) return m;
    const int b = m >> 12, t = m & 4095, sh = (g == 1) ? 2 : 4;
    return (b << 12) + (t & ((1 << sh) - 1)) * (4096 >> sh) + (t >> sh);
}
typedef short bf16x8_t __attribute__((ext_vector_type(8)));
typedef short s16x4_t __attribute__((ext_vector_type(4)));
typedef float f32x16 __attribute__((ext_vector_type(16)));
typedef __bf16 bf16x2v __attribute__((ext_vector_type(2)));
typedef float f32x2v __attribute__((ext_vector_type(2)));
__device__ __forceinline__ unsigned cvtpk(float lo, float hi) { f32x2v v = {lo, hi}; bf16x2v b = __builtin_convertvector(v, bf16x2v); return __builtin_bit_cast(unsigned, b); }
__device__ __forceinline__ int crow(int r, int hi) { return (r & 3) + 8 * (r >> 2) + 4 * hi; }
__device__ __forceinline__ s16x4_t vtr(const LAS unsigned char* p) { return __builtin_bit_cast(s16x4_t, __builtin_amdgcn_ds_read_tr16_b64_v4i16((LAS s16x4_t*)p)); }

constexpr int AT_K = 0, AT_V = 49152, AT_OST = 98304, AT_WSF = 132096;
constexpr float SM_C2 = 0.125f * 1.4426950408889634f;

__device__ __forceinline__ void p3_swa(const Frame& F, const Args& a) {
    unsigned char* ws = a.ws;
    const bf16* Q = (const bf16*)(ws + WS_Q); const bf16* K = (const bf16*)(ws + WS_K); const bf16* V = (const bf16*)(ws + WS_V);
    bf16* OG = (bf16*)(ws + WS_OG); float* LSE = (float*)(ws + WS_LSE);
    const int tid = F.tid, lane = F.lane, w = F.wave, l31 = lane & 31, hi = lane >> 5;
    const LAS unsigned char* ldsK = F.lds + AT_K; const LAS unsigned char* ldsV = F.lds + AT_V;
    LAS float* wsf = (LAS float*)(F.lds + AT_WSF) + w * 64;
    LAS bf16* stg = (LAS bf16*)(F.lds + AT_OST) + w * 2048;
    for (int it = F.vcu; it < 1536; it += F.G) {
        const int g = it >> 9; int rem = it & 511;
        const int j = rem & 7; rem >>= 3; const int b = rem & 3; rem >>= 2;
        const int sh = (g == 0) ? 0 : (g == 1) ? 2 : 4, nqb = 16 >> sh, qb = rem % nqb, r = rem / nqb, Lg = 4096 >> sh;
        const int hh = g * 8 + j;
        const int seqbase = (b << 12) + r * Lg;
        const int k0 = qb * 256 - 128;
        {
            v4u kr[6], vr[6];
#pragma unroll
            for (int k = 0; k < 6; ++k) { const int cidx = tid + 512 * k, row = cidx >> 3, c = cidx & 7; int srow = k0 + row; srow = srow < 0 ? 0 : srow;
                const size_t off = (size_t)(seqbase + srow) * DQKV + hh * HD + c * 8;
                kr[k] = *(const GAS v4u*)(K + off); vr[k] = *(const GAS v4u*)(V + off); }
#pragma unroll
            for (int k = 0; k < 6; ++k) { const int cidx = tid + 512 * k, row = cidx >> 3, c = cidx & 7;
                *(LAS v4u*)(F.lds + AT_K + row * 128 + ((c ^ ((row >> 1) & 7)) << 4)) = kr[k];
                *(LAS v4u*)(F.lds + AT_V + (row >> 3) * 1024 + (c >> 2) * 512 + (row & 7) * 64 + (c & 3) * 16) = vr[k]; }
        }
        bf16x8_t qf[4];
        { const bf16* qp = Q + (size_t)(seqbase + qb * 256 + 32 * w + l31) * DQKV + hh * HD + 8 * hi;
#pragma unroll
          for (int ks = 0; ks < 4; ++ks) qf[ks] = *(const GAS bf16x8_t*)(qp + 16 * ks); }
        __syncthreads();
        f32x16 S[5];
#pragma unroll
        for (int kb = 0; kb < 5; ++kb) {
            S[kb] = (f32x16){0.f,0.f,0.f,0.f,0.f,0.f,0.f,0.f,0.f,0.f,0.f,0.f,0.f,0.f,0.f,0.f};
            const int krow = 32 * (w + kb) + l31;
#pragma unroll
            for (int ks = 0; ks < 4; ++ks) { const int c = 2 * ks + hi;
                const bf16x8_t af = *(const LAS bf16x8_t*)(ldsK + krow * 128 + ((c ^ ((l31 >> 1) & 7)) << 4));
                S[kb] = __builtin_amdgcn_mfma_f32_32x32x16_bf16(af, qf[ks], S[kb], 0, 0, 0); }
        }
        const float NEGB = -1e30f;
#pragma unroll
        for (int rr = 0; rr < 16; ++rr) { const int kl = crow(rr, hi); if (kl < l31) S[0][rr] = NEGB; if (kl > l31) S[4][rr] = NEGB; }
        if (qb == 0) {
#pragma unroll
            for (int kb = 0; kb < 4; ++kb) if (w + kb < 4) {
#pragma unroll
                for (int rr = 0; rr < 16; ++rr) S[kb][rr] = NEGB; }
        }
        float mx = NEGB;
#pragma unroll
        for (int kb = 0; kb < 5; ++kb)
#pragma unroll
            for (int rr = 0; rr < 16; ++rr) mx = fmaxf(mx, S[kb][rr]);
        mx = fmaxf(mx, __shfl_xor(mx, 32));
        const float mc = mx * SM_C2; float lsum = 0.f;
#pragma unroll
        for (int kb = 0; kb < 5; ++kb)
#pragma unroll
            for (int rr = 0; rr < 16; ++rr) { const float p = __builtin_amdgcn_exp2f(S[kb][rr] * SM_C2 - mc); S[kb][rr] = p; lsum += p; }
        lsum += __shfl_xor(lsum, 32);
        f32x16 O[2];
        O[0] = (f32x16){0.f,0.f,0.f,0.f,0.f,0.f,0.f,0.f,0.f,0.f,0.f,0.f,0.f,0.f,0.f,0.f}; O[1] = O[0];
        const int vbase = (4 * hi + ((lane & 15) >> 2)) * 64 + ((lane >> 4) & 1) * 32 + (lane & 3) * 8;
#pragma unroll
        for (int kb = 0; kb < 5; ++kb)
#pragma unroll
            for (int s = 0; s < 2; ++s) {
                v4u pw; pw.x = cvtpk(S[kb][8 * s + 0], S[kb][8 * s + 1]); pw.y = cvtpk(S[kb][8 * s + 2], S[kb][8 * s + 3]); pw.z = cvtpk(S[kb][8 * s + 4], S[kb][8 * s + 5]); pw.w = cvtpk(S[kb][8 * s + 6], S[kb][8 * s + 7]);
                const bf16x8_t pa = __builtin_bit_cast(bf16x8_t, pw);
                const int kg0 = 4 * (w + kb) + 2 * s;
#pragma unroll
                for (int nb = 0; nb < 2; ++nb) {
                    const s16x4_t lo = vtr(ldsV + kg0 * 1024 + nb * 512 + vbase), hv = vtr(ldsV + (kg0 + 1) * 1024 + nb * 512 + vbase);
                    const bf16x8_t vb = (bf16x8_t){lo[0], lo[1], lo[2], lo[3], hv[0], hv[1], hv[2], hv[3]};
                    O[nb] = __builtin_amdgcn_mfma_f32_32x32x16_bf16(pa, vb, O[nb], 0, 0, 0);
                }
            }
        if (hi == 0) wsf[l31] = lsum;
        LDS_WAIT(); asm volatile("" ::: "memory");
#pragma unroll
        for (int rr = 0; rr < 16; ++rr) { const int qr = crow(rr, hi); const float rl = __builtin_amdgcn_rcpf(wsf[qr]);
            stg[qr * 64 + l31] = (bf16)f2bf(O[0][rr] * rl); stg[qr * 64 + 32 + l31] = (bf16)f2bf(O[1][rr] * rl); }
        LDS_WAIT(); asm volatile("" ::: "memory");
        const int mq0 = (b << 12) + r, qi0 = qb * 256 + 32 * w;
#pragma unroll
        for (int i = 0; i < 4; ++i) { const int row = i * 8 + (lane >> 3), ch = lane & 7; const v4u v = *(const LAS v4u*)(stg + row * 64 + ch * 8);
            const int m = mq0 + ((qi0 + row) << sh);
            *(GAS v4u*)(OG + ((size_t)g * M_PROMPT + m) * 512 + j * HD + ch * 8) = v; }
        if (hi == 0) { const int m = mq0 + ((qi0 + l31) << sh); LSE[((size_t)g * M_PROMPT + m) * 8 + j] = mc + __builtin_amdgcn_logf(lsum); }
        __syncthreads();
    }
}

struct SaPass { v4u q0, q1; f32x4 k0, k1, k2, k3, v0, v1, v2, v3; };
__device__ __forceinline__ SaPass sa_load(int idx, const Args& a, const bf16* Q, const bf16* K, const bf16* V, int m, int j, int bs, int tl, int ksub, int part) {
    const int g = idx / 9, ps = idx - 9 * g, d = (g == 0) ? 1 : (g == 1) ? 4 : 16, W = 128 * d, h = g * 8 + j;
    const float* cache = (g == 0) ? a.in[4] : (g == 1) ? a.in[5] : a.in[6];
    SaPass P; const GAS v4u* qp = (const GAS v4u*)(Q + (size_t)m * DQKV + h * HD + 16 * part); P.q0 = qp[0]; P.q1 = qp[1];
    const int i = ps * 16 + ksub; const bool act = i <= 128; const int rel = tl - i * d;
    const f32x4 z4 = (f32x4){0.f, 0.f, 0.f, 0.f};
    P.k0 = z4; P.k1 = z4; P.k2 = z4; P.k3 = z4; P.v0 = z4; P.v1 = z4; P.v2 = z4; P.v3 = z4;
    if (act) {
        if (rel >= 0) { const size_t off = (size_t)(m - i * d) * DQKV + h * HD + 16 * part;
            P.k0 = ((const GAS f32x4*)(K + off))[0]; P.k1 = ((const GAS f32x4*)(K + off))[1]; P.v0 = ((const GAS f32x4*)(V + off))[0]; P.v1 = ((const GAS f32x4*)(V + off))[1]; }
        else { const size_t offk = ((((size_t)bs * 2 + 0) * W + (W + rel)) * 8 + j) * HD + 16 * part, offv = offk + (size_t)W * 8 * HD;
            const GAS f32x4* kp = (const GAS f32x4*)(cache + offk); const GAS f32x4* vp = (const GAS f32x4*)(cache + offv);
            P.k0 = kp[0]; P.k1 = kp[1]; P.k2 = kp[2]; P.k3 = kp[3]; P.v0 = vp[0]; P.v1 = vp[1]; P.v2 = vp[2]; P.v3 = vp[3]; }
    }
    return P;
}
__device__ __forceinline__ void sa_proc(const SaPass P, int idx, const Args& a, int j, int bs, int tl, int ksub, int part, float& mrun, float& sum, float (&o)[16]) {
    const int g = idx / 9, ps = idx - 9 * g, d = (g == 0) ? 1 : (g == 1) ? 4 : 16, W = 128 * d;
    const int i = ps * 16 + ksub; const bool act = i <= 128; const int rel = tl - i * d;
    float q[16], kx[16], vx[16];
    q[0] = bflo(P.q0.x); q[1] = bfhi(P.q0.x); q[2] = bflo(P.q0.y); q[3] = bfhi(P.q0.y); q[4] = bflo(P.q0.z); q[5] = bfhi(P.q0.z); q[6] = bflo(P.q0.w); q[7] = bfhi(P.q0.w);
    q[8] = bflo(P.q1.x); q[9] = bfhi(P.q1.x); q[10] = bflo(P.q1.y); q[11] = bfhi(P.q1.y); q[12] = bflo(P.q1.z); q[13] = bfhi(P.q1.z); q[14] = bflo(P.q1.w); q[15] = bfhi(P.q1.w);
    if (rel >= 0) {
        const v4u k0 = __builtin_bit_cast(v4u, P.k0), k1 = __builtin_bit_cast(v4u, P.k1), v0 = __builtin_bit_cast(v4u, P.v0), v1 = __builtin_bit_cast(v4u, P.v1);
        kx[0] = bflo(k0.x); kx[1] = bfhi(k0.x); kx[2] = bflo(k0.y); kx[3] = bfhi(k0.y); kx[4] = bflo(k0.z); kx[5] = bfhi(k0.z); kx[6] = bflo(k0.w); kx[7] = bfhi(k0.w);
        kx[8] = bflo(k1.x); kx[9] = bfhi(k1.x); kx[10] = bflo(k1.y); kx[11] = bfhi(k1.y); kx[12] = bflo(k1.z); kx[13] = bfhi(k1.z); kx[14] = bflo(k1.w); kx[15] = bfhi(k1.w);
        vx[0] = bflo(v0.x); vx[1] = bfhi(v0.x); vx[2] = bflo(v0.y); vx[3] = bfhi(v0.y); vx[4] = bflo(v0.z); vx[5] = bfhi(v0.z); vx[6] = bflo(v0.w); vx[7] = bfhi(v0.w);
        vx[8] = bflo(v1.x); vx[9] = bfhi(v1.x); vx[10] = bflo(v1.y); vx[11] = bfhi(v1.y); vx[12] = bflo(v1.z); vx[13] = bfhi(v1.z); vx[14] = bflo(v1.w); vx[15] = bfhi(v1.w);
    } else {
        kx[0] = P.k0.x; kx[1] = P.k0.y; kx[2] = P.k0.z; kx[3] = P.k0.w; kx[4] = P.k1.x; kx[5] = P.k1.y; kx[6] = P.k1.z; kx[7] = P.k1.w;
        kx[8] = P.k2.x; kx[9] = P.k2.y; kx[10] = P.k2.z; kx[11] = P.k2.w; kx[12] = P.k3.x; kx[13] = P.k3.y; kx[14] = P.k3.z; kx[15] = P.k3.w;
        vx[0] = P.v0.x; vx[1] = P.v0.y; vx[2] = P.v0.z; vx[3] = P.v0.w; vx[4] = P.v1.x; vx[5] = P.v1.y; vx[6] = P.v1.z; vx[7] = P.v1.w;
        vx[8] = P.v2.x; vx[9] = P.v2.y; vx[10] = P.v2.z; vx[11] = P.v2.w; vx[12] = P.v3.x; vx[13] = P.v3.y; vx[14] = P.v3.z; vx[15] = P.v3.w;
        if (act && (W + rel >= DEC_T) && (g != 0 || tl == 0)) {
            const size_t offk = ((((size_t)bs * 2 + 0) * W + (W + rel - DEC_T)) * 8 + j) * HD + 16 * part, offv = offk + (size_t)W * 8 * HD;
            float* okv = a.out + ((g == 0) ? O_KV128S : (g == 1) ? O_KV512S : O_KV2048S);
            GAS f32x4* ko = (GAS f32x4*)(okv + offk); GAS f32x4* vo = (GAS f32x4*)(okv + offv);
            ko[0] = P.k0; ko[1] = P.k1; ko[2] = P.k2; ko[3] = P.k3; vo[0] = P.v0; vo[1] = P.v1; vo[2] = P.v2; vo[3] = P.v3;
        }
    }
    float s = 0.f;
#pragma unroll
    for (int k = 0; k < 16; ++k) s += q[k] * kx[k];
    s += __shfl_xor(s, 1); s += __shfl_xor(s, 2);
    s *= 0.125f;
    if (act) {
        const float mn = fmaxf(mrun, s), sc = __expf(mrun - mn), p = __expf(s - mn);
        sum = sum * sc + p; mrun = mn;
#pragma unroll
        for (int k = 0; k < 16; ++k) o[k] = o[k] * sc + p * vx[k];
    }
}
__device__ __forceinline__ void p3_sample_attn(const Frame& F, const Args& a) {
    unsigned char* ws = a.ws;
    const bf16* Q = (const bf16*)(ws + WS_Q); const bf16* K = (const bf16*)(ws + WS_K); const bf16* V = (const bf16*)(ws + WS_V);
    bf16* Bb = (bf16*)(ws + WS_B);
    const int lane = F.lane, ksub = lane >> 2, part = lane & 3, half = F.wave & 1;
    const int it = F.vcu * 4 + (F.wave >> 1);
    LAS float* xch = (LAS float*)(F.lds + RING_OFF) + (F.wave >> 1) * 80;
    float mrun = -1e30f, sum = 0.f; float o[16];
#pragma unroll
    for (int k = 0; k < 16; ++k) o[k] = 0.f;
    const bool live = it < M_SAMPLE * 8;
    const int m = M_PROMPT + (live ? (it >> 3) : 0), j = it & 7, bs = (m - M_PROMPT) >> 2, tl = (m - M_PROMPT) & 3;
    if (live) {
        SaPass PA = sa_load(half, a, Q, K, V, m, j, bs, tl, ksub, part);
#pragma unroll 1
        for (int idx = half; idx < 27; idx += 2) {
            const int nx = (idx + 2 < 27) ? idx + 2 : idx;
            const SaPass PB = sa_load(nx, a, Q, K, V, m, j, bs, tl, ksub, part);
            sa_proc(PA, idx, a, j, bs, tl, ksub, part, mrun, sum, o);
            PA = PB;
        }
    }
    const float M = wave_max(mrun), fl = __expf(mrun - M);
    sum *= fl;
#pragma unroll
    for (int k = 0; k < 16; ++k) o[k] *= fl;
#pragma unroll
    for (int off = 4; off < 64; off <<= 1) {
        sum += __shfl_xor(sum, off);
#pragma unroll
        for (int k = 0; k < 16; ++k) o[k] += __shfl_xor(o[k], off);
    }
    if (half == 1 && ksub == 0) { xch[part * 18] = M; xch[part * 18 + 1] = sum;
#pragma unroll
        for (int k = 0; k < 16; ++k) xch[part * 18 + 2 + k] = o[k]; }
    __syncthreads();
    if (half == 0 && ksub == 0 && live) {
        const float M1 = xch[part * 18], s1 = xch[part * 18 + 1];
        const float Mn = fmaxf(M, M1), f0 = __expf(M - Mn), f1 = __expf(M1 - Mn);
        const float rl = 1.0f / (sum * f0 + s1 * f1);
        float r[16];
#pragma unroll
        for (int k = 0; k < 16; ++k) r[k] = (o[k] * f0 + xch[part * 18 + 2 + k] * f1) * rl;
        v4u o0, o1; o0.x = pk2(r[0], r[1]); o0.y = pk2(r[2], r[3]); o0.z = pk2(r[4], r[5]); o0.w = pk2(r[6], r[7]);
        o1.x = pk2(r[8], r[9]); o1.y = pk2(r[10], r[11]); o1.z = pk2(r[12], r[13]); o1.w = pk2(r[14], r[15]);
        GAS v4u* op = (GAS v4u*)(Bb + (size_t)m * D_A + j * HD + 16 * part); op[0] = o0; op[1] = o1;
    }
    __syncthreads();
}

__device__ __forceinline__ void p3_combine(const Frame& F, const Args& a) {
    unsigned char* ws = a.ws;
    const bf16* OG = (const bf16*)(ws + WS_OG); const float* LSE = (const float*)(ws + WS_LSE); bf16* Bb = (bf16*)(ws + WS_B);
    const size_t gt = (size_t)blockIdx.x * 512 + F.tid, NT = (size_t)F.G * 512, total = (size_t)M_PROMPT * 64;
    for (size_t i0 = gt; i0 < total; i0 += 8 * NT) {
        v4u a0[8], a1[8], a2[8]; float l0[8], l1[8], l2[8];
#pragma unroll
        for (int k = 0; k < 8; ++k) { const size_t i = i0 + k * NT; if (i < total) { const size_t m = i >> 6; const int c8 = (int)(i & 63), j = c8 >> 3;
            l0[k] = LSE[((size_t)0 * M_PROMPT + m) * 8 + j]; l1[k] = LSE[((size_t)1 * M_PROMPT + m) * 8 + j]; l2[k] = LSE[((size_t)2 * M_PROMPT + m) * 8 + j];
            a0[k] = ((const GAS v4u*)(OG + ((size_t)0 * M_PROMPT + m) * 512))[c8]; a1[k] = ((const GAS v4u*)(OG + ((size_t)1 * M_PROMPT + m) * 512))[c8]; a2[k] = ((const GAS v4u*)(OG + ((size_t)2 * M_PROMPT + m) * 512))[c8]; } }
#pragma unroll
        for (int k = 0; k < 8; ++k) { const size_t i = i0 + k * NT; if (i < total) { const size_t m = i >> 6; const int c8 = (int)(i & 63);
            const float mx = fmaxf(l0[k], fmaxf(l1[k], l2[k]));
            float w0 = __builtin_amdgcn_exp2f(l0[k] - mx), w1 = __builtin_amdgcn_exp2f(l1[k] - mx), w2 = __builtin_amdgcn_exp2f(l2[k] - mx);
            const float rs = 1.0f / (w0 + w1 + w2); w0 *= rs; w1 *= rs; w2 *= rs;
            const v4u x0 = a0[k], x1 = a1[k], x2 = a2[k];
            v4u o;
            o.x = pk2(w0 * bflo(x0.x) + w1 * bflo(x1.x) + w2 * bflo(x2.x), w0 * bfhi(x0.x) + w1 * bfhi(x1.x) + w2 * bfhi(x2.x));
            o.y = pk2(w0 * bflo(x0.y) + w1 * bflo(x1.y) + w2 * bflo(x2.y), w0 * bfhi(x0.y) + w1 * bfhi(x1.y) + w2 * bfhi(x2.y));
            o.z = pk2(w0 * bflo(x0.z) + w1 * bflo(x1.z) + w2 * bflo(x2.z), w0 * bfhi(x0.z) + w1 * bfhi(x1.z) + w2 * bfhi(x2.z));
            o.w = pk2(w0 * bflo(x0.w) + w1 * bflo(x1.w) + w2 * bflo(x2.w), w0 * bfhi(x0.w) + w1 * bfhi(x1.w) + w2 * bfhi(x2.w));
            ((GAS v4u*)(Bb + m * 512))[c8] = o; } }
    }
}

constexpr int MX_V = 0;
__device__ __forceinline__ float ssv_rstd(const float* SSV, int m) {
    const f32x4 s0 = ((const GAS f32x4*)(SSV + (size_t)m * 8))[0], s1 = ((const GAS f32x4*)(SSV + (size_t)m * 8))[1];
    const float ss = ((s0.x + s0.y) + (s0.z + s0.w)) + ((s1.x + s1.y) + (s1.z + s1.w));
    return __builtin_amdgcn_rsqf(ss * (1.f / D_A) + EPS);
}
constexpr int MX_C = 32768, MX_CLD = 132;
__device__ __forceinline__ void p3_mix(const Frame& F, const Args& a) {
    unsigned char* ws = a.ws;
    const bf16* U = (const bf16*)(ws + WS_U); const bf16* VA = (const bf16*)(ws + WS_VA); const bf16* WSB = (const bf16*)(ws + WS_WSB); const float* SSV = (const float*)(ws + WS_SSV);
    bf16* Ab = (bf16*)(ws + WS_A);
    const float* g_v = a.in[9]; const float* b_s = a.in[11];
    const int tid = F.tid, lane = F.lane, w = F.wave, l31 = lane & 31, hi = lane >> 5;
    const LAS unsigned char* ldsV = F.lds + MX_V;
    LAS float* ldsC = (LAS float*)(F.lds + MX_C);
    const int tb = w >> 1, cb = w & 1;
    auto LOAD = [&](int it, v4u (&x)[4], v4u (&u)[4], float (&rs)[4], float (&bi)[4]) {
        const int g = it & 3, chunk0 = (it >> 2) * 128;
#pragma unroll
        for (int k = 0; k < 4; ++k) { const int cidx = tid + 512 * k, s = cidx >> 4, c = cidx & 15; const size_t off = (size_t)(chunk0 + s) * D_A + g * 128 + c * 8;
            x[k] = *(const GAS v4u*)(VA + off); u[k] = *(const GAS v4u*)(U + off); rs[k] = ssv_rstd(SSV, chunk0 + s); bi[k] = b_s[g * 128 + s]; }
    };
    auto PROC = [&](int it, const v4u (&xx)[4], const v4u (&uu)[4], const float (&rsv)[4], const float (&bi)[4]) {
        const int g = it & 3, ck = it >> 2, chunk0 = ck * 128;
        const bool lastc = (ck & 31) == 31; const int bb = ck >> 5;
        const bf16* wrow = WSB + ((size_t)g * 128 + 32 * tb + l31) * 128 + 4 * hi;
        v2u wa[8][2];
#pragma unroll
        for (int ks = 0; ks < 8; ++ks) if (ks <= 2 * tb + 1) { wa[ks][0] = *(const GAS v2u*)(wrow + 16 * ks); wa[ks][1] = *(const GAS v2u*)(wrow + 16 * ks + 8); }
#pragma unroll
        for (int k = 0; k < 4; ++k) {
            const int cidx = tid + 512 * k, s = cidx >> 4, c = cidx & 15;
            const float rs = rsv[k]; const v4u x = xx[k];
            const f32x4 g0 = *(const GAS f32x4*)(g_v + g * 128 + c * 8), g1 = *(const GAS f32x4*)(g_v + g * 128 + c * 8 + 4);
            const float v0 = bflo(x.x) * rs * g0.x, v1 = bfhi(x.x) * rs * g0.y, v2 = bflo(x.y) * rs * g0.z, v3 = bfhi(x.y) * rs * g0.w;
            const float v4 = bflo(x.z) * rs * g1.x, v5 = bfhi(x.z) * rs * g1.y, v6 = bflo(x.w) * rs * g1.z, v7 = bfhi(x.w) * rs * g1.w;
            v4u o; o.x = pk2(v0, v1); o.y = pk2(v2, v3); o.z = pk2(v4, v5); o.w = pk2(v6, v7);
            *(LAS v4u*)(F.lds + MX_V + ((s >> 3) * 4 + (c >> 2)) * 512 + (s & 7) * 64 + (c & 3) * 16) = o;
            if (lastc) { float* cv = a.out + O_CVP + ((size_t)bb * 128 + s) * D_A + g * 128 + c * 8; *(GAS f32x4*)cv = (f32x4){v0, v1, v2, v3}; *(GAS f32x4*)(cv + 4) = (f32x4){v4, v5, v6, v7}; }
        }
        __syncthreads();
        f32x16 C[2];
        C[0] = (f32x16){0.f,0.f,0.f,0.f,0.f,0.f,0.f,0.f,0.f,0.f,0.f,0.f,0.f,0.f,0.f,0.f}; C[1] = C[0];
        const int vbase = (4 * hi + ((lane & 15) >> 2)) * 64 + ((lane >> 4) & 1) * 32 + (lane & 3) * 8;
#pragma unroll
        for (int ks = 0; ks < 8; ++ks) {
            if (ks <= 2 * tb + 1) {
                const bf16x8_t af = __builtin_bit_cast(bf16x8_t, (v4u){wa[ks][0].x, wa[ks][0].y, wa[ks][1].x, wa[ks][1].y});
#pragma unroll
                for (int nb = 0; nb < 2; ++nb) {
                    const int st = (2 * ks) * 4 + (2 * cb + nb);
                    const s16x4_t lo = vtr(ldsV + st * 512 + vbase), hv = vtr(ldsV + (st + 4) * 512 + vbase);
                    const bf16x8_t vb = (bf16x8_t){lo[0], lo[1], lo[2], lo[3], hv[0], hv[1], hv[2], hv[3]};
                    C[nb] = __builtin_amdgcn_mfma_f32_32x32x16_bf16(af, vb, C[nb], 0, 0, 0);
                }
            }
        }
#pragma unroll
        for (int rr = 0; rr < 16; ++rr) { const int t = 32 * tb + crow(rr, hi);
#pragma unroll
            for (int nb = 0; nb < 2; ++nb) ldsC[t * MX_CLD + 64 * cb + 32 * nb + l31] = C[nb][rr]; }
        __syncthreads();
#pragma unroll
        for (int k = 0; k < 4; ++k) {
            const int cidx = tid + 512 * k, s = cidx >> 4, c = cidx & 15;
            const f32x4 m0 = *(const LAS f32x4*)(ldsC + s * MX_CLD + c * 8), m1 = *(const LAS f32x4*)(ldsC + s * MX_CLD + c * 8 + 4);
            const v4u u = uu[k]; const float b = bi[k];
            v4u o; o.x = pk2(bflo(u.x) * (m0.x + b), bfhi(u.x) * (m0.y + b)); o.y = pk2(bflo(u.y) * (m0.z + b), bfhi(u.y) * (m0.w + b));
            o.z = pk2(bflo(u.z) * (m1.x + b), bfhi(u.z) * (m1.y + b)); o.w = pk2(bflo(u.w) * (m1.z + b), bfhi(u.w) * (m1.w + b));
            *(GAS v4u*)(Ab + (size_t)(chunk0 + s) * D_A + g * 128 + c * 8) = o;
        }
    };
    v4u xa[4], ua[4], xb[4], ub[4]; float ra[4], ba[4], rb[4], bb2[4];
    int it = F.vcu;
    if (it < 512) {
        LOAD(it, xa, ua, ra, ba);
        for (;;) {
            int n = it + F.G; bool hn = n < 512;
            if (hn) LOAD(n, xb, ub, rb, bb2);
            PROC(it, xa, ua, ra, ba);
            if (!hn) break;
            it = n; n = it + F.G; hn = n < 512;
            if (hn) LOAD(n, xa, ua, ra, ba);
            PROC(it, xb, ub, rb, bb2);
            if (!hn) break;
            it = n;
        }
    }
    __syncthreads();
}
__device__ __forceinline__ void p3_mix_sample(const Frame& F, const Args& a) {
    unsigned char* ws = a.ws;
    const int gw = F.vcu * NWAVES + F.wave, NGW = F.G * NWAVES, lane = F.lane;
    const bf16* U = (const bf16*)(ws + WS_U); const bf16* VA = (const bf16*)(ws + WS_VA); const float* SSV = (const float*)(ws + WS_SSV);
    bf16* Ab = (bf16*)(ws + WS_A);
    const float* w_s = a.in[10]; const float* b_s = a.in[11]; const float* g_v = a.in[9];
    for (int it = gw; it < M_SAMPLE * 4; it += NGW) {
        const int m = M_PROMPT + (it >> 2), g = it & 3;
        const int chunk0 = M_PROMPT + ((m - M_PROMPT) & ~3), tl = (m - M_PROMPT) & 3;
        const float gv0 = g_v[g * 128 + 2 * lane], gv1 = g_v[g * 128 + 2 * lane + 1];
        float acc0 = 0.f, acc1 = 0.f;
        const float* wrow = w_s + ((size_t)g * 128 + tl) * 128;
        float wv[4], rs[4]; unsigned vv[4];
#pragma unroll
        for (int s = 0; s < 4; ++s) { const int sc = s <= tl ? s : tl; wv[s] = wrow[sc]; rs[s] = ssv_rstd(SSV, chunk0 + sc); vv[s] = ((const GAS unsigned*)(VA + (size_t)(chunk0 + sc) * D_A + g * 128))[lane]; }
        const float bias = b_s[g * 128 + tl];
        const unsigned uu = ((const GAS unsigned*)(U + (size_t)m * D_A + g * 128))[lane];
#pragma unroll
        for (int s = 0; s < 4; ++s) if (s <= tl) {
            const float n0 = bflo(vv[s]) * rs[s] * gv0, n1 = bfhi(vv[s]) * rs[s] * gv1;
            acc0 += wv[s] * bf2f((unsigned short)f2bf(n0)); acc1 += wv[s] * bf2f((unsigned short)f2bf(n1));
            if (s == tl) { float* cv = a.out + O_CVS + (size_t)(m - M_PROMPT) * D_A + g * 128 + 2 * lane; cv[0] = n0; cv[1] = n1; }
        }
        ((GAS unsigned*)(Ab + (size_t)m * D_A + g * 128))[lane] = pk2(bflo(uu) * (acc0 + bias), bfhi(uu) * (acc1 + bias));
    }
}

#define SG_ROWS() const int lane = F.lane, w = F.wave, tok = lane & 15, fq = lane >> 4, sidx = 16 * w + tok, m = M_PROMPT + sidx; (void)tok
#define SG_TILE(rg, cg) const int lane = F.lane, w = F.wave, tok = lane & 15, fq = lane >> 4, sidx = 32 * (rg) + 16 * (w >> 2) + tok, m = M_PROMPT + sidx, c0 = 64 * (cg) + 16 * (w & 3), r0s = 32 * (rg), cg0 = 64 * (cg); LAS float* red = (LAS float*)(F.lds + RING_OFF); (void)tok; (void)m
__device__ __forceinline__ void s1_job(const Frame& F, const Args& a, int cb) {
    unsigned char* ws = a.ws; SG_ROWS();
    sg::f32x4 acc[4]; float ssu = 0.f;
#pragma unroll
    for (int nt = 0; nt < 4; ++nt) acc[nt] = (sg::f32x4){0.f, 0.f, 0.f, 0.f};
    sg::core<4, false>(acc, ssu, ws + WS_H, D, m, (const unsigned short*)(ws + WS_WIN), D, 64 * cb, 0, D, lane);
    const int b = sidx >> 2, tl = sidx & 3;
    if (cb < 8) {
#pragma unroll
        for (int nt = 0; nt < 4; ++nt) { v2u o; o.x = sg::cvt2(sg::gelu(acc[nt][0]), sg::gelu(acc[nt][1])); o.y = sg::cvt2(sg::gelu(acc[nt][2]), sg::gelu(acc[nt][3]));
            *(GAS v2u*)((bf16*)(ws + WS_U) + (size_t)m * D_A + 64 * cb + 16 * nt + 4 * fq) = o; }
    } else if (cb < 16) {
        float ss = 0.f;
#pragma unroll
        for (int nt = 0; nt < 4; ++nt) { const float g0 = sg::gelu(acc[nt][0]), g1 = sg::gelu(acc[nt][1]), g2 = sg::gelu(acc[nt][2]), g3 = sg::gelu(acc[nt][3]);
            ss += (g0 * g0 + g1 * g1) + (g2 * g2 + g3 * g3); v2u o; o.x = sg::cvt2(g0, g1); o.y = sg::cvt2(g2, g3);
            *(GAS v2u*)((bf16*)(ws + WS_VA) + (size_t)m * D_A + 64 * (cb - 8) + 16 * nt + 4 * fq) = o; }
        ss += __shfl_xor(ss, 16); ss += __shfl_xor(ss, 32);
        if (fq == 0) ((float*)(ws + WS_SSV))[(size_t)m * 8 + (cb - 8)] = ss;
    } else if (cb < 88) {
        const bool isv = cb >= 64, isk = !isv && cb >= 40; const int hd = cb - (isv ? 64 : isk ? 40 : 16), g = hd >> 3, hh = hd & 7;
        float y[4][4];
#pragma unroll
        for (int nt = 0; nt < 4; ++nt)
#pragma unroll
            for (int r = 0; r < 4; ++r) y[nt][r] = acc[nt][r];
        if (!isv) {
            float ss = 0.f;
#pragma unroll
            for (int nt = 0; nt < 4; ++nt) ss += (y[nt][0] * y[nt][0] + y[nt][1] * y[nt][1]) + (y[nt][2] * y[nt][2] + y[nt][3] * y[nt][3]);
            ss += __shfl_xor(ss, 16); ss += __shfl_xor(ss, 32);
            const float rn = __builtin_amdgcn_rsqf(ss * (1.f / HD) + EPS);
            const float* gp = isk ? a.in[13] : a.in[12];
#pragma unroll
            for (int nt = 0; nt < 4; ++nt) { const f32x4 gg = *(const GAS f32x4*)(gp + 16 * nt + 4 * fq); y[nt][0] *= rn * gg.x; y[nt][1] *= rn * gg.y; y[nt][2] *= rn * gg.z; y[nt][3] *= rn * gg.w; }
            const float* rt = (const float*)(ws + WS_ROT) + (size_t)(4096 + tl) * 16 + 8 * (fq & 1);
            const f32x4 t0 = *(const GAS f32x4*)rt, t1 = *(const GAS f32x4*)(rt + 4);
            const float cs[4] = {t0.x, t0.z, t1.x, t1.z}, sn[4] = {t0.y, t0.w, t1.y, t1.w};
#pragma unroll
            for (int r = 0; r < 4; ++r) { const float pr = __shfl_xor(y[0][r], 32); y[0][r] = (fq < 2) ? (y[0][r] * cs[r] - pr * sn[r]) : (y[0][r] * cs[r] + pr * sn[r]); }
        }
        bf16* dst = (bf16*)(ws + (isv ? WS_V : isk ? WS_K : WS_Q)) + (size_t)m * DQKV + hd * HD;
#pragma unroll
        for (int nt = 0; nt < 4; ++nt) { v2u o; o.x = sg::cvt2(y[nt][0], y[nt][1]); o.y = sg::cvt2(y[nt][2], y[nt][3]); *(GAS v2u*)(dst + 16 * nt + 4 * fq) = o; }
        if (isk || isv) {
            const int W = 128 << (2 * g); const size_t oks = (g == 0) ? O_KV128S : (g == 1) ? O_KV512S : O_KV2048S;
            float* o = a.out + oks + ((((size_t)b * 2 + (isv ? 1 : 0)) * W + (W - DEC_T + tl)) * 8 + hh) * HD + 4 * fq;
#pragma unroll
            for (int nt = 0; nt < 4; ++nt) *(GAS f32x4*)(o + 16 * nt) = (f32x4){y[nt][0], y[nt][1], y[nt][2], y[nt][3]};
        }
    } else {
        bf16* dst = (bf16*)(ws + (cb < 104 ? WS_GA : WS_GB)) + (size_t)m * D + 64 * (cb - (cb < 104 ? 88 : 104));
#pragma unroll
        for (int nt = 0; nt < 4; ++nt) { v2u o; o.x = sg::cvt2(sg::sigm(acc[nt][0]), sg::sigm(acc[nt][1])); o.y = sg::cvt2(sg::sigm(acc[nt][2]), sg::sigm(acc[nt][3]));
            *(GAS v2u*)(dst + 16 * nt + 4 * fq) = o; }
    }
}
__device__ __forceinline__ void s3_job(const Frame& F, const Args& a, int j) {
    unsigned char* ws = a.ws; const int which = j & 1, rg = (j >> 1) & 3, cg = j >> 3; SG_TILE(rg, cg);
    sg::f32x4 acc[1]; float ssu = 0.f;
    sg::core8<false, 2>(acc[0], ssu, red, ws + (which ? WS_B : WS_A), D_A, M_PROMPT + r0s, (const unsigned short*)(ws + (which ? WS_WOB : WS_WOA)), D_A, cg0, 0, lane, w);
    const v2u gt = *(const GAS v2u*)((const bf16*)(ws + (which ? WS_GB : WS_GA)) + (size_t)m * D + c0 + 4 * fq);
    float* o = (float*)(ws + WS_MGS) + (size_t)sidx * D + c0 + 4 * fq;
    atomicAdd(o + 0, bflo(gt.x) * acc[0][0]); atomicAdd(o + 1, bfhi(gt.x) * acc[0][1]); atomicAdd(o + 2, bflo(gt.y) * acc[0][2]); atomicAdd(o + 3, bfhi(gt.y) * acc[0][3]);
}
__device__ __forceinline__ void s4_job(const Frame& F, const Args& a, int j) {
    unsigned char* ws = a.ws; const int kq = j & 3, rg = (j >> 2) & 3, cg = j >> 4; SG_TILE(rg, cg);
    sg::f32x4 acc[1]; float ssu = 0.f;
    sg::core8<true, 1>(acc[0], ssu, red, ws + WS_MGS, D, r0s, (const unsigned short*)(ws + WS_WO), D, cg0, 256 * kq, lane, w);
    float* o = (float*)(ws + WS_X1S) + (size_t)sidx * D + c0 + 4 * fq;
    atomicAdd(o + 0, acc[0][0]); atomicAdd(o + 1, acc[0][1]); atomicAdd(o + 2, acc[0][2]); atomicAdd(o + 3, acc[0][3]);
}
__device__ __forceinline__ void s5_job(const Frame& F, const Args& a, int j) {
    unsigned char* ws = a.ws; const int rg = j & 3, cg = j >> 2; SG_TILE(rg, cg);
    sg::f32x4 acc[1]; float ss = 0.f;
    sg::core8<true, 4>(acc[0], ss, red, ws + WS_X1S, D, r0s, (const unsigned short*)(ws + WS_WFF1), D, cg0, 0, lane, w);
    const float r = __builtin_amdgcn_rsqf(ss * (1.f / D) + EPS);
    float fv[4];
#pragma unroll
    for (int e = 0; e < 4; ++e) { const float t = fmaxf(acc[0][e] * r, 0.f); fv[e] = t * t; }
    v2u o; o.x = sg::cvt2(fv[0], fv[1]); o.y = sg::cvt2(fv[2], fv[3]);
    *(GAS v2u*)((bf16*)(ws + WS_F) + (size_t)m * D_FF + c0 + 4 * fq) = o;
    { const int row = F.tid >> 2, col = 4 * j + (F.tid & 3); ((float*)(ws + WS_X2S))[(size_t)row * D + col] = ((const float*)(ws + WS_X1S))[(size_t)row * D + col]; }
}
__device__ __forceinline__ void s6_job(const Frame& F, const Args& a, int j) {
    unsigned char* ws = a.ws; const int kq = j & 3, rg = (j >> 2) & 3, cg = j >> 4; SG_TILE(rg, cg);
    sg::f32x4 acc[1]; float ssu = 0.f;
    sg::core8<false, 4>(acc[0], ssu, red, ws + WS_F, D_FF, M_PROMPT + r0s, (const unsigned short*)(ws + WS_WFF2), D_FF, cg0, 1024 * kq, lane, w);
    float* o = (float*)(ws + WS_X2S) + (size_t)sidx * D + c0 + 4 * fq;
    atomicAdd(o + 0, acc[0][0]); atomicAdd(o + 1, acc[0][1]); atomicAdd(o + 2, acc[0][2]); atomicAdd(o + 3, acc[0][3]);
}
__device__ __forceinline__ void s7_job(const Frame& F, const Args& a, int j) {
    unsigned char* ws = a.ws; const int rg = j & 3, cg = j >> 2; SG_TILE(rg, cg);
    sg::f32x4 acc1[1], acc2[1]; float ss = 0.f, ssu = 0.f;
    sg::core8<true, 4>(acc1[0], ss, red, ws + WS_X2S, D, r0s, (const unsigned short*)(ws + WS_WPG), D, cg0, 0, lane, w);
    sg::core8<false, 1>(acc2[0], ssu, red, ws + WS_PE, D_PLE, M_PROMPT + r0s, (const unsigned short*)(ws + WS_WPP), D_PLE, cg0, 0, lane, w);
    const float r = __builtin_amdgcn_rsqf(ss * (1.f / D) + EPS);
    const size_t off = (size_t)sidx * D + c0 + 4 * fq;
    const f32x4 x2 = *(const GAS f32x4*)((const float*)(ws + WS_X2S) + off);
    f32x4 y; y.x = x2.x + sg::sigm(acc1[0][0] * r) * acc2[0][0]; y.y = x2.y + sg::sigm(acc1[0][1] * r) * acc2[0][1]; y.z = x2.z + sg::sigm(acc1[0][2] * r) * acc2[0][2]; y.w = x2.w + sg::sigm(acc1[0][3] * r) * acc2[0][3];
    *(GAS f32x4*)(a.out + O_YS + off) = y;
}

__global__ void __launch_bounds__(NWAVES * 64, 2) mega_fwd(Args args) {
    extern __shared__ __attribute__((aligned(16))) unsigned char lds[];
    Frame F;
    F.lds = (LAS unsigned char*)lds;
    F.tid = threadIdx.x; F.lane = F.tid & 63; F.wave = __builtin_amdgcn_readfirstlane(F.tid >> 6);
    F.G = gridDim.x; { const int bx = blockIdx.x; F.vcu = (F.G % 8 == 0) ? (bx % 8) * (F.G / 8) + bx / 8 : bx; }
#define REFRAME() do { int t_ = threadIdx.x; asm volatile("" : "+v"(t_)); F.tid = t_; F.lane = t_ & 63; F.wave = __builtin_amdgcn_readfirstlane(t_ >> 6); } while (0)
    unsigned char* ws = args.ws;
    for (int u = F.tid; u < (LDS_BYTES - LDSCTL_OFF) / 4; u += NWAVES * 64) ((LAS unsigned*)(F.lds + LDSCTL_OFF))[u] = 0u;
    __syncthreads();
    volatile LAS unsigned* MISC = (volatile LAS unsigned*)(F.lds + MISC_OFF);
    XcdBarrier bar = xcd_barrier_post((unsigned*)(ws + WS_CTL) + CW_BAR, MISC + 8);
    int bar_i = 0;
#define GRID_BAR(BN) do { xcd_barrier<BN>(bar, args.in[6], args.out, (long)bar_i * (256 * 448) + (long)blockIdx.x * (448 * (BN))); bar_i += (BN); } while (0)
    const int G = F.G, bx = (int)blockIdx.x;

    REFRAME();
    p0_prologue(F, args);
    GRID_BAR(8);
    { pg8::Gemm g{(const pg8::bf16_t*)(ws + WS_PE), (const pg8::bf16_t*)(ws + WS_WPP), M_PROMPT, D, D_PLE}; pg8::HalfOrder S{bx - 128};
      pg8::EpiGate<2> E{(bf16*)(ws + WS_PJB), nullptr, nullptr, D};
      pg8::gemm_phase<pg8::EpiGate<2>, pg8::HalfOrder, true, true, pg8::KvCopy>(F.lds + RING_OFF, g, S, E, pg8::KvCopy{{args.in[6], args.out, pg8::KVC_TOTAL, {}}, 1920}); }
    { pg8::Gemm g{(const pg8::bf16_t*)(ws + WS_H), (const pg8::bf16_t*)(ws + WS_WIN), M_PROMPT, D_IN, D}; pg8::StaticOrder S; S.init(M_PROMPT, D_IN, G, bx);
      pg8::EpiIn E{ws, args.out, args.in[12], args.in[13], (PG8_LAS float*)(F.lds + ROTT_OFF)};
      pg8::gemm_phase<pg8::EpiIn, pg8::StaticOrder, true, true, pg8::KvCopy>(F.lds + RING_OFF, g, S, E, pg8::KvCopy{{args.in[6], args.out, pg8::KVC_TOTAL, {}}, 0}); }
    REFRAME(); if (bx >= 128 && bx < 128 + 120) s1_job(F, args, bx - 128);
    GRID_BAR(28);
    REFRAME(); p3_swa(F, args);
    REFRAME(); p3_sample_attn(F, args);
    REFRAME(); p3_mix(F, args);
    REFRAME(); p3_mix_sample(F, args);
    GRID_BAR(28);
    { pg8::Gemm g{(const pg8::bf16_t*)(ws + WS_A), (const pg8::bf16_t*)(ws + WS_WOA), M_PROMPT, D, D_A}; pg8::StaticOrder S; S.init(M_PROMPT, D, G, bx);
      pg8::EpiGate<0> E{(bf16*)(ws + WS_T1B), (const bf16*)(ws + WS_GA), nullptr, D};
      pg8::gemm_phase<pg8::EpiGate<0>, pg8::StaticOrder, true, true, pg8::KvCopy>(F.lds + RING_OFF, g, S, E, pg8::KvCopy{{args.in[6], args.out, pg8::KVC_TOTAL, {}}, 2176}); }
    REFRAME(); p3_combine(F, args);
    REFRAME(); if (bx < 128) s3_job(F, args, bx);
    GRID_BAR(8);
    { pg8::Gemm g{(const pg8::bf16_t*)(ws + WS_B), (const pg8::bf16_t*)(ws + WS_WOB), M_PROMPT, D, D_A}; pg8::StaticOrder S; S.init(M_PROMPT, D, G, bx);
      pg8::EpiGate<1> E{(bf16*)(ws + WS_MG), (const bf16*)(ws + WS_GB), (const bf16*)(ws + WS_T1B), D};
      pg8::gemm_phase<pg8::EpiGate<1>, pg8::StaticOrder, true, true, pg8::KvCopy>(F.lds + RING_OFF, g, S, E, pg8::KvCopy{{args.in[6], args.out, pg8::KVC_TOTAL, {}}, 2432}); }
    REFRAME(); s4_job(F, args, bx);
    GRID_BAR(10);
    { pg8::Gemm g{(const pg8::bf16_t*)(ws + WS_MG), (const pg8::bf16_t*)(ws + WS_WO), M_PROMPT, D, D}; pg8::StaticOrder S; S.init(M_PROMPT, D, G, bx);
      pg8::EpiResid<false> E{args.in[0], (bf16*)(ws + WS_XB1), (float*)(ws + WS_SSQ1), nullptr};
      pg8::gemm_phase<pg8::EpiResid<false>, pg8::StaticOrder, true, true, pg8::KvCopy>(F.lds + RING_OFF, g, S, E, pg8::KvCopy{{args.in[6], args.out, pg8::KVC_TOTAL, {}}, 2688}); }
    REFRAME(); s5_job(F, args, bx);
    GRID_BAR(10);
    { pg8::Gemm g{(const pg8::bf16_t*)(ws + WS_XB1), (const pg8::bf16_t*)(ws + WS_WFF1), M_PROMPT, D_FF, D}; pg8::StaticOrder S; S.init(M_PROMPT, D_FF, G, bx);
      pg8::EpiFF1 E{(bf16*)(ws + WS_F), D_FF};
      pg8::gemm_phase<pg8::EpiFF1, pg8::StaticOrder, true, true, pg8::KvCopy>(F.lds + RING_OFF, g, S, E, pg8::KvCopy{{args.in[6], args.out, pg8::KVC_TOTAL, {}}, 2944}); }
    REFRAME(); s6_job(F, args, bx);
    GRID_BAR(10);
    { pg8::Gemm g{(const pg8::bf16_t*)(ws + WS_F), (const pg8::bf16_t*)(ws + WS_WFF2), M_PROMPT, D, D_FF}; pg8::StaticOrder S; S.init(M_PROMPT, D, G, bx);
      pg8::EpiResid<true> E{ws + WS_XB1, (bf16*)(ws + WS_XB2), (float*)(ws + WS_SSQ2), (const float*)(ws + WS_SSQ1)};
      pg8::gemm_phase<pg8::EpiResid<true>, pg8::StaticOrder, true, true, pg8::KvCopy>(F.lds + RING_OFF, g, S, E, pg8::KvCopy{{args.in[6], args.out, pg8::KVC_TOTAL, {}}, 3968}); }
    REFRAME(); if (bx < 64) s7_job(F, args, bx);
    GRID_BAR(10);
    { pg8::Gemm g{(const pg8::bf16_t*)(ws + WS_XB2), (const pg8::bf16_t*)(ws + WS_WPG), M_PROMPT, D, D}; pg8::StaticOrder S; S.init(M_PROMPT, D, G, bx);
      pg8::EpiFinal E{args.out, (const bf16*)(ws + WS_XB2), (const bf16*)(ws + WS_PJB), (const float*)(ws + WS_SSQ2)};
      pg8::gemm_phase<pg8::EpiFinal, pg8::StaticOrder, true, true, pg8::KvCopy>(F.lds + RING_OFF, g, S, E, pg8::KvCopy{{args.in[6], args.out, pg8::KVC_TOTAL, {}}, 4224}); }
}

extern "C" void kernel_launch(void* const* d_in, const int* in_sizes, int n_in, void* d_out, int out_size, void* d_ws, size_t ws_size, hipStream_t stream) {
    static int grid = 0;
    if (grid == 0) {
        if (n_in != 23 || out_size != (int)O_END || ws_size < WS_END2) { fprintf(stderr, "kernel_launch: unexpected shapes: n_in %d out %d ws %zu (need %zu)\n", n_in, out_size, ws_size, (size_t)WS_END2); grid = -1; return; }
        int dev = 0, cus = 0, per_cu = 0;
        if (hipGetDevice(&dev) != hipSuccess || hipDeviceGetAttribute(&cus, hipDeviceAttributeMultiprocessorCount, dev) != hipSuccess) { grid = -1; return; }
        if (hipFuncSetAttribute((const void*)mega_fwd, hipFuncAttributeMaxDynamicSharedMemorySize, LDS_BYTES) != hipSuccess) { fprintf(stderr, "kernel_launch: hipFuncSetAttribute failed\n"); grid = -1; return; }
        if (hipOccupancyMaxActiveBlocksPerMultiprocessor(&per_cu, (const void*)mega_fwd, NWAVES * 64, LDS_BYTES) != hipSuccess || per_cu < 1) { fprintf(stderr, "kernel_launch: occupancy query says %d blocks/CU\n", per_cu); }
        (void)hipGetLastError();
        grid = cus;
        if (grid != 256) { fprintf(stderr, "kernel_launch: this kernel's static work split needs 256 CUs, device has %d\n", cus); grid = -1; return; }
    }
    if (grid < 0) return;
    if (hipMemsetAsync((char*)d_ws + WS_CTL, 0, CTL_ZERO_BYTES, stream) != hipSuccess) { fprintf(stderr, "kernel_launch: memset failed\n"); return; }
    Args a{};
    for (int i = 0; i < 23; ++i) a.in[i] = (const float*)d_in[i];
    a.out = (float*)d_out; a.ws = (unsigned char*)d_ws;
    hipLaunchKernelGGL(mega_fwd, dim3(grid), dim3(NWAVES * 64), LDS_BYTES, stream, a);
}
```

```cpp
#include <hip/hip_runtime.h>
#include <cstdio>
#include <cstdint>
#include <cmath>
constexpr int NWAVES = 8;
constexpr int D = 1024, SEQ = 4096, NBATCH = 4, M_PROMPT = NBATCH * SEQ;
constexpr int DEC_B = 32, DEC_T = 4, M_SAMPLE = DEC_B * DEC_T;
constexpr int MV = M_PROMPT + M_SAMPLE;
constexpr int MP = 16640;
constexpr int PAST_LEN = 8192;
constexpr int D_A = 512, NHB = 24, HD = 64, DQKV = NHB * HD, D_IN = 2 * D_A + 3 * DQKV + 2 * D, D_FF = 4096, D_PLE = 256;
constexpr int C_U = 0, C_VA = 512, C_Q = 1024, C_K = 2560, C_V = 4096, C_GA = 5632, C_GB = 6656;
constexpr float EPS = 1e-6f;
static_assert(D_IN == 7680, "D_IN");

constexpr size_t O_YP = 0, O_YS = 16777216, O_KV128P = O_YS + 131072, O_KV512P = O_KV128P + 524288, O_KV2048P = O_KV512P + 2097152,
                 O_KV128S = O_KV2048P + 8388608, O_KV512S = O_KV128S + 4194304, O_KV2048S = O_KV512S + 16777216,
                 O_CVP = O_KV2048S + 67108864, O_CVS = O_CVP + 262144, O_END = O_CVS + 65536;
static_assert(O_END == 116326400, "out size");

constexpr size_t MiB = 1u << 20;
constexpr size_t WS_CTL = 0, CTL_ZERO_BYTES = 65536;
constexpr size_t WS_WIN = 2 * MiB, WS_WOA = 17 * MiB, WS_WOB = 18 * MiB, WS_WO = 19 * MiB, WS_WFF1 = 21 * MiB, WS_WFF2 = 29 * MiB, WS_WPG = 37 * MiB, WS_WPP = 39 * MiB;
constexpr size_t WS_H = 40 * MiB, WS_PE = 73 * MiB, WS_U = 82 * MiB, WS_VA = 99 * MiB, WS_Q = 116 * MiB, WS_K = 165 * MiB, WS_V = 214 * MiB;
constexpr size_t WS_F = WS_Q;
constexpr size_t WS_GA = 263 * MiB, WS_GB = 296 * MiB, WS_A = 329 * MiB, WS_B = 346 * MiB, WS_MG = 363 * MiB;
constexpr size_t WS_BIG = 396 * MiB;
constexpr size_t WS_T1 = WS_BIG + 70 * MiB, WS_T2 = WS_BIG + 135 * MiB, WS_PJ = WS_BIG + 200 * MiB, WS_FF = WS_BIG + 265 * MiB;
constexpr size_t WS_END = WS_BIG + 488 * MiB;
constexpr size_t WS_OG = WS_END;
constexpr size_t WS_LSE = WS_OG + 48 * MiB;
constexpr size_t WS_SSV = WS_LSE + 2 * MiB;
constexpr size_t WS_WSB = WS_SSV + 1 * MiB;
constexpr size_t WS_SSQ1 = WS_WSB + 1 * MiB, WS_SSQ2 = WS_SSQ1 + 2 * MiB;
constexpr size_t WS_ROT = WS_SSQ2 + 2 * MiB;
constexpr size_t WS_MGS = WS_ROT + 1 * MiB, WS_X1S = WS_MGS + 1 * MiB, WS_X2S = WS_X1S + 1 * MiB;
constexpr size_t WS_END2 = WS_X2S + 1 * MiB;
constexpr size_t WS_T1B = WS_BIG, WS_PJB = WS_BIG + 33 * MiB;
constexpr size_t WS_XB1 = WS_H, WS_XB2 = WS_MG;
static_assert((size_t)MP * 1024 * 2 <= 33 * MiB && (size_t)MP * 256 * 2 <= 9 * MiB && (size_t)MP * 512 * 2 <= 17 * MiB && (size_t)MP * 1536 * 2 <= 49 * MiB, "ws map 1");
static_assert((size_t)MP * 4096 * 2 <= 147 * MiB && (size_t)MP * 1024 * 4 <= 65 * MiB && (size_t)MP * 4096 * 4 <= 260 * MiB && (size_t)MP * 7680 * 4 <= 488 * MiB, "ws map 2");


constexpr int CW_BAR = 4096;

constexpr int RING_OFF = 0, RING_BYTES = 131072;
constexpr int LDSCTL_OFF = RING_BYTES, MISC_OFF = LDSCTL_OFF + 320;
constexpr int ROTT_OFF = LDSCTL_OFF + 1024, LDS_BYTES = ROTT_OFF + 16384 + 1024;


namespace pg8 {
#define PG8_LAS __attribute__((address_space(3)))
typedef unsigned short bf16_t;
typedef short bf16x8 __attribute__((ext_vector_type(8)));
typedef float f32x4 __attribute__((ext_vector_type(4)));
typedef unsigned u32x4 __attribute__((ext_vector_type(4)));
constexpr int BM = 256, BK = 64, HALF = 128, HTB = HALF * BK * 2  , STAGE_BYTES = 8 * HTB, NXCD = 8, WGM = 8;

__host__ __device__ __forceinline__ int lds_byte(int r, int c) { const int st = (r >> 4) * 2 + (c >> 5), rr = r & 15, cc = c & 31, ob = rr * 64 + cc * 2; return st * 1024 + (ob ^ (((ob >> 9) & 1) << 5)); }
__host__ __device__ __forceinline__ void stage_rc(int b, int& R, int& C) { const int st = b / 1024, sb = b % 1024, swz = sb ^ (((sb >> 9) & 1) << 5); R = (st >> 1) * 16 + swz / 64; C = (st & 1) * 32 + (swz % 64) / 2; }
__host__ __device__ __forceinline__ int perm32(int rho) { const int n = rho >> 4, i = rho & 15; return 8 * (i >> 2) + 4 * n + (i & 3); }

struct Unit { int pm, pn, L; };
struct Gemm { const bf16_t* A; const bf16_t* Bt; int M, N, K; };

struct StaticOrder {
    int nM, nN, nwg, G, c;
    __host__ __device__ void init(int M, int N, int G_, int c_) { nM = M / BM; nN = N / BM; nwg = nM * nN; G = G_; c = c_; }
    __host__ __device__ bool next(int i, Unit& u) const {
        const long L = (long)i * G + c; if (L >= nwg) return false; u.L = (int)L;
        int wgid = (int)L; { const int q = nwg / NXCD, r = nwg % NXCD, xcd = wgid % NXCD, off = wgid / NXCD; wgid = (xcd < r ? xcd * (q + 1) : r * (q + 1) + (xcd - r) * q) + off; }
        const int nig = WGM * nN, gid = wgid / nig, fm = gid * WGM, gsz = (nM - fm) < WGM ? (nM - fm) : WGM;
        u.pm = fm + ((wgid % nig) % gsz); u.pn = (wgid % nig) / gsz; return true;
    }
    __device__ __forceinline__ void a_ready(const Unit&) const {}
    __device__ __forceinline__ void done(const Unit&) const {}
};

__device__ __forceinline__ unsigned cvt_pk_bf16(float lo, float hi) { unsigned r; asm volatile("v_cvt_pk_bf16_f32 %0, %1, %2" : "=v"(r) : "v"(lo), "v"(hi)); return r; }
typedef float f32x2 __attribute__((ext_vector_type(2)));
struct EpiF32 {
    static constexpr bool PERM = false, AFTER_DRAIN = false, HEADMAP = false;
    float* C; int ldc; const float* bias;
    __device__ __forceinline__ void operator()(const f32x4 (&acc)[2][2][4][2], const Unit& u, int wr, int wc, int fr, int fq) const {
        const int row0 = u.pm * BM + wr * 64 + fr, col0 = u.pn * BM + wc * 32 + 4 * fq;
        f32x4 bv[2][2];
#pragma unroll
        for (int bj = 0; bj < 2; ++bj)
#pragma unroll
            for (int n = 0; n < 2; ++n) bv[bj][n] = bias ? *(const f32x4*)(bias + col0 + bj * HALF + n * 16) : (f32x4){0.f, 0.f, 0.f, 0.f};
#pragma unroll
        for (int ai = 0; ai < 2; ++ai)
#pragma unroll
            for (int m = 0; m < 4; ++m) { float* rowp = C + (size_t)(row0 + ai * HALF + m * 16) * ldc + col0;
#pragma unroll
                for (int bj = 0; bj < 2; ++bj)
#pragma unroll
                    for (int n = 0; n < 2; ++n) *(f32x4*)(rowp + bj * HALF + n * 16) = acc[ai][bj][m][n] + bv[bj][n]; }
    }
};
struct HalfOrder {
    int c2;
    __device__ __forceinline__ bool next(int i, Unit& u) const { if (c2 < 0 || i >= 2) return false; const int L = i * 128 + c2; u.pm = L >> 2; u.pn = L & 3; u.L = L; return true; }
    __device__ __forceinline__ void a_ready(const Unit&) const {}
    __device__ __forceinline__ void done(const Unit&) const {}
};
__device__ __forceinline__ float ep_sum_xor16(float x) { const unsigned xi = __builtin_bit_cast(unsigned, x); const auto r = __builtin_amdgcn_permlane16_swap(xi, xi, false, false); return __builtin_bit_cast(float, (unsigned)r[0]) + __builtin_bit_cast(float, (unsigned)r[1]); }
__device__ __forceinline__ float ep_sum_xor32(float x) { const unsigned xi = __builtin_bit_cast(unsigned, x); const auto r = __builtin_amdgcn_permlane32_swap(xi, xi, false, false); return __builtin_bit_cast(float, (unsigned)r[0]) + __builtin_bit_cast(float, (unsigned)r[1]); }
__device__ __forceinline__ float ep_get_xor16(float x, bool odd_row) { const unsigned xi = __builtin_bit_cast(unsigned, x); const auto r = __builtin_amdgcn_permlane16_swap(xi, xi, false, false); return __builtin_bit_cast(float, odd_row ? (unsigned)r[0] : (unsigned)r[1]); }
__device__ __forceinline__ float ep_sigmoid(float x) { return __builtin_amdgcn_rcpf(1.0f + __builtin_amdgcn_exp2f(-1.4426950408889634f * x)); }
__device__ __forceinline__ float ep_gelu(float x) { const float y = 0.7978845608028654f * (x + 0.044715f * x * x * x); return x * ep_sigmoid(2.0f * y); }
typedef __bf16 ep_bf16x2 __attribute__((ext_vector_type(2)));
__device__ __forceinline__ unsigned ep_cvt2(float lo, float hi) { f32x2 v = {lo, hi}; ep_bf16x2 b = __builtin_convertvector(v, ep_bf16x2); return __builtin_bit_cast(unsigned, b); }
__device__ __forceinline__ u32x4 ep_pack8(const float (&v)[8]) { u32x4 w; w.x = ep_cvt2(v[0], v[1]); w.y = ep_cvt2(v[2], v[3]); w.z = ep_cvt2(v[4], v[5]); w.w = ep_cvt2(v[6], v[7]); return w; }
__device__ __forceinline__ float ep_bflo(unsigned w) { return __builtin_bit_cast(float, w << 16); }
__device__ __forceinline__ float ep_bfhi(unsigned w) { return __builtin_bit_cast(float, w & 0xffff0000u); }
__device__ __forceinline__ void ep_unpack8(const u32x4 w, float (&v)[8]) { v[0] = ep_bflo(w.x); v[1] = ep_bfhi(w.x); v[2] = ep_bflo(w.y); v[3] = ep_bfhi(w.y); v[4] = ep_bflo(w.z); v[5] = ep_bfhi(w.z); v[6] = ep_bflo(w.w); v[7] = ep_bfhi(w.w); }
#define EP_X8(x, a_, b_) float x[8] = {a_[0], a_[1], a_[2], a_[3], b_[0], b_[1], b_[2], b_[3]}

constexpr int EP_MPROMPT = 16384, EP_MV = 16512, EP_SEQ = 4096, EP_DECT = 4;
__device__ __forceinline__ int ep_perm_row(int m, int g) {
    if (g == 0 || m >= EP_MPROMPT) return m;
    const int b = m >> 12, t = m & 4095, sh = (g == 1) ? 2 : 4;
    return (b << 12) + (t & ((1 << sh) - 1)) * (4096 >> sh) + (t >> sh);
}

struct EpiIn {
    static constexpr bool PERM = true, AFTER_DRAIN = false, HEADMAP = true;
    unsigned char* ws; float* out; const float* g_q; const float* g_k; PG8_LAS float* rott;
    __device__ __forceinline__ void state_out(const float (&y0)[8], const float (&y1)[8], int row, int g, int hh, int c, int fq) const {
        const int W = 128 << (2 * g);
        const size_t okp = (g == 0) ? O_KV128P : (g == 1) ? O_KV512P : O_KV2048P, oks = (g == 0) ? O_KV128S : (g == 1) ? O_KV512S : O_KV2048S;
        float* o = nullptr;
        if (row < EP_MPROMPT) { const int b = row >> 12, t = row & 4095; if (t >= EP_SEQ - W) o = out + okp + ((((size_t)b * 2 + c) * W + (t - (EP_SEQ - W))) * 8 + hh) * 64; }
        else if (row < EP_MV) { const int b = (row - EP_MPROMPT) >> 2, t = (row - EP_MPROMPT) & 3; o = out + oks + ((((size_t)b * 2 + c) * W + (W - EP_DECT + t)) * 8 + hh) * 64; }
        if (o) { o += 8 * fq; __builtin_nontemporal_store((f32x4){y0[0], y0[1], y0[2], y0[3]}, (f32x4*)o); __builtin_nontemporal_store((f32x4){y0[4], y0[5], y0[6], y0[7]}, (f32x4*)(o + 4));
                 __builtin_nontemporal_store((f32x4){y1[0], y1[1], y1[2], y1[3]}, (f32x4*)(o + 32)); __builtin_nontemporal_store((f32x4){y1[4], y1[5], y1[6], y1[7]}, (f32x4*)(o + 36)); }
    }
    __device__ __forceinline__ void operator()(const f32x4 (&acc)[2][2][4][2], const Unit& u, int wr, int wc, int fr, int fq) const {
        const int pn = u.pn, row0 = u.pm * BM + wr * 64 + fr, cw = 64 * wc + 8 * fq;
        bf16_t* const U = (bf16_t*)(ws + WS_U); bf16_t* const VA = (bf16_t*)(ws + WS_VA); bf16_t* const V = (bf16_t*)(ws + WS_V); float* const SSV = (float*)(ws + WS_SSV); const float* const ROT = (const float*)(ws + WS_ROT);
        if (pn < 2) {
#pragma unroll
            for (int ai = 0; ai < 2; ++ai)
#pragma unroll
                for (int m = 0; m < 4; ++m) { const int row = row0 + ai * HALF + m * 16;
#pragma unroll
                    for (int bj = 0; bj < 2; ++bj) { EP_X8(x, acc[ai][bj][m][0], acc[ai][bj][m][1]);
#pragma unroll
                        for (int e = 0; e < 8; ++e) x[e] = ep_gelu(x[e]);
                        *(u32x4*)(U + (size_t)row * 512 + 256 * pn + cw + 32 * bj) = ep_pack8(x); } }
        } else if (pn < 4) {
#pragma unroll
            for (int ai = 0; ai < 2; ++ai)
#pragma unroll
                for (int m = 0; m < 4; ++m) { const int row = row0 + ai * HALF + m * 16; float ss = 0.f;
#pragma unroll
                    for (int bj = 0; bj < 2; ++bj) { EP_X8(x, acc[ai][bj][m][0], acc[ai][bj][m][1]);
#pragma unroll
                        for (int e = 0; e < 8; ++e) { x[e] = ep_gelu(x[e]); ss += x[e] * x[e]; }
                        *(u32x4*)(VA + (size_t)row * 512 + 256 * (pn - 2) + cw + 32 * bj) = ep_pack8(x); }
                    ss = ep_sum_xor32(ep_sum_xor16(ss));
                    if (fq == 0) SSV[(size_t)row * 8 + (pn - 2) * 4 + wc] = ss; }
        } else if (pn < 16) {
            const bool isk = pn >= 10; const int hd = 4 * (pn - (isk ? 10 : 4)) + wc, g = hd >> 3, hh = hd & 7;
            const float* gq_ = g_q; const float* gk_ = g_k; asm volatile("" : "+s"(gq_), "+s"(gk_));
            const float* gp = (isk ? gk_ : gq_) + 8 * fq;
            const f32x4 ga0 = *(const f32x4*)gp, ga1 = *(const f32x4*)(gp + 4), gb0 = *(const f32x4*)(gp + 32), gb1 = *(const f32x4*)(gp + 36);
            const float gn0[8] = {ga0[0], ga0[1], ga0[2], ga0[3], ga1[0], ga1[1], ga1[2], ga1[3]}, gn1[8] = {gb0[0], gb0[1], gb0[2], gb0[3], gb1[0], gb1[1], gb1[2], gb1[3]};
            bf16_t* dst = (bf16_t*)(ws + (isk ? WS_K : WS_Q));
            { const int t = (wr * 4 + wc) * 64 + fq * 16 + fr, lr = t >> 1, hf = t & 1;
              const float* rt = ROT + (size_t)((u.pm * BM + lr) & 4095) * 16 + hf * 8;
              const f32x4 a0 = *(const f32x4*)rt, a1 = *(const f32x4*)(rt + 4);
              *(PG8_LAS f32x4*)(rott + lr * 16 + hf * 8) = a0; *(PG8_LAS f32x4*)(rott + lr * 16 + hf * 8 + 4) = a1;
              asm volatile("s_waitcnt lgkmcnt(0)" ::: "memory"); __builtin_amdgcn_s_barrier(); }
#pragma unroll
            for (int ai = 0; ai < 2; ++ai)
#pragma unroll
                for (int m = 0; m < 4; ++m) { const int row = row0 + ai * HALF + m * 16;
                    EP_X8(y0, acc[ai][0][m][0], acc[ai][0][m][1]); EP_X8(y1, acc[ai][1][m][0], acc[ai][1][m][1]);
                    float ss = 0.f;
#pragma unroll
                    for (int e = 0; e < 8; ++e) ss += y0[e] * y0[e] + y1[e] * y1[e];
                    ss = ep_sum_xor32(ep_sum_xor16(ss));
                    const float r = __builtin_amdgcn_rsqf(ss * (1.f / 64.f) + 1e-6f);
#pragma unroll
                    for (int e = 0; e < 8; ++e) { y0[e] *= r * gn0[e]; y1[e] *= r * gn1[e]; }
                    const PG8_LAS float* rt = rott + (wr * 64 + fr + ai * HALF + m * 16) * 16;
                    const f32x4 t0 = *(const PG8_LAS f32x4*)rt, t1 = *(const PG8_LAS f32x4*)(rt + 4), t2 = *(const PG8_LAS f32x4*)(rt + 8), t3 = *(const PG8_LAS f32x4*)(rt + 12);
                    const float cs[8] = {t0[0], t0[2], t1[0], t1[2], t2[0], t2[2], t3[0], t3[2]}, sn[8] = {t0[1], t0[3], t1[1], t1[3], t2[1], t2[3], t3[1], t3[3]};
#pragma unroll
                    for (int e = 0; e < 8; ++e) { const float pr = ep_get_xor16(y0[e], (fq & 1) != 0);
                        if (fq == 0) y0[e] = y0[e] * cs[e] - pr * sn[e]; else if (fq == 1) y0[e] = y0[e] * cs[e] + pr * sn[e]; }
                    bf16_t* d = dst + (size_t)ep_perm_row(row, g) * 1536 + hd * 64 + 8 * fq;
                    *(u32x4*)d = ep_pack8(y0); *(u32x4*)(d + 32) = ep_pack8(y1);
                    if (isk) state_out(y0, y1, row, g, hh, 0, fq);
                    asm volatile("" ::: "memory");
                }
        } else if (pn < 22) {
            const int hd = 4 * (pn - 16) + wc, g = hd >> 3, hh = hd & 7;
#pragma unroll
            for (int ai = 0; ai < 2; ++ai)
#pragma unroll
                for (int m = 0; m < 4; ++m) { const int row = row0 + ai * HALF + m * 16;
                    EP_X8(y0, acc[ai][0][m][0], acc[ai][0][m][1]); EP_X8(y1, acc[ai][1][m][0], acc[ai][1][m][1]);
                    bf16_t* d = V + (size_t)ep_perm_row(row, g) * 1536 + hd * 64 + 8 * fq;
                    *(u32x4*)d = ep_pack8(y0); *(u32x4*)(d + 32) = ep_pack8(y1);
                    state_out(y0, y1, row, g, hh, 1, fq);
                    asm volatile("" ::: "memory");
                }
        } else {
            bf16_t* dst = (bf16_t*)(ws + ((pn < 26) ? WS_GA : WS_GB)); const int ct = 256 * ((pn - 22) & 3);
#pragma unroll
            for (int ai = 0; ai < 2; ++ai)
#pragma unroll
                for (int m = 0; m < 4; ++m) { const int row = row0 + ai * HALF + m * 16;
#pragma unroll
                    for (int bj = 0; bj < 2; ++bj) { EP_X8(x, acc[ai][bj][m][0], acc[ai][bj][m][1]);
#pragma unroll
                        for (int e = 0; e < 8; ++e) x[e] = ep_sigmoid(x[e]);
                        *(u32x4*)(dst + (size_t)row * 1024 + ct + cw + 32 * bj) = ep_pack8(x); } }
        }
    }
};

template <int MODE> struct EpiGate {
    static constexpr bool PERM = true, AFTER_DRAIN = false, HEADMAP = false;
    bf16_t* O; const bf16_t* G; const bf16_t* T; int ldc;
    __device__ __forceinline__ void operator()(const f32x4 (&acc)[2][2][4][2], const Unit& u, int wr, int wc, int fr, int fq) const {
        const int row0 = u.pm * BM + wr * 64 + fr, col0 = u.pn * BM + wc * 32 + 8 * fq;
#pragma unroll
        for (int ai = 0; ai < 2; ++ai)
#pragma unroll
            for (int m = 0; m < 4; ++m) { const size_t ro = (size_t)(row0 + ai * HALF + m * 16) * ldc + col0;
#pragma unroll
                for (int bj = 0; bj < 2; ++bj) { EP_X8(x, acc[ai][bj][m][0], acc[ai][bj][m][1]);
                    if (MODE < 2) { float gv[8]; ep_unpack8(*(const u32x4*)(G + ro + bj * HALF), gv);
#pragma unroll
                        for (int e = 0; e < 8; ++e) x[e] *= gv[e]; }
                    if (MODE == 1) { float tv[8]; ep_unpack8(*(const u32x4*)(T + ro + bj * HALF), tv);
#pragma unroll
                        for (int e = 0; e < 8; ++e) x[e] += tv[e]; }
                    *(u32x4*)(O + ro + bj * HALF) = ep_pack8(x); }
                asm volatile("" ::: "memory"); }
    }
};

__device__ __forceinline__ float ep_rstd16(const float* SSQ, int row);
template <bool XIN_BF16> struct EpiResid {
    static constexpr bool PERM = true, AFTER_DRAIN = false, HEADMAP = false;
    const void* xold; bf16_t* XB; float* SSQ; const float* SSQ_IN;
    __device__ __forceinline__ void operator()(const f32x4 (&acc)[2][2][4][2], const Unit& u, int wr, int wc, int fr, int fq) const {
        const int row0 = u.pm * BM + wr * 64 + fr, col0 = u.pn * BM + wc * 32 + 8 * fq;
#pragma unroll
        for (int ai = 0; ai < 2; ++ai)
#pragma unroll
            for (int m = 0; m < 4; ++m) { const int row = row0 + ai * HALF + m * 16; float ss = 0.f; float r2 = 1.f; if (SSQ_IN) { const float r = ep_rstd16(SSQ_IN, row); r2 = r * r; }
#pragma unroll
                for (int bj = 0; bj < 2; ++bj) { EP_X8(x, acc[ai][bj][m][0], acc[ai][bj][m][1]); const size_t o = (size_t)row * 1024 + col0 + bj * HALF;
#pragma unroll
                    for (int e = 0; e < 8; ++e) x[e] *= r2;
                    if (XIN_BF16) { float xo[8]; ep_unpack8(*(const u32x4*)((const bf16_t*)xold + o), xo);
#pragma unroll
                        for (int e = 0; e < 8; ++e) x[e] += xo[e]; }
                    else { const f32x4 a0 = __builtin_nontemporal_load((const f32x4*)((const float*)xold + o)), a1 = __builtin_nontemporal_load((const f32x4*)((const float*)xold + o + 4));
                        x[0] += a0[0]; x[1] += a0[1]; x[2] += a0[2]; x[3] += a0[3]; x[4] += a1[0]; x[5] += a1[1]; x[6] += a1[2]; x[7] += a1[3]; }
#pragma unroll
                    for (int e = 0; e < 8; ++e) ss += x[e] * x[e];
                    *(u32x4*)(XB + o) = ep_pack8(x); }
                ss = ep_sum_xor32(ep_sum_xor16(ss));
                if (fq == 0) SSQ[(size_t)row * 16 + u.pn * 4 + wc] = ss;
                asm volatile("" ::: "memory"); }
    }
};
__device__ __forceinline__ float ep_rstd16(const float* SSQ, int row) {
    const f32x4 s0 = *(const f32x4*)(SSQ + (size_t)row * 16), s1 = *(const f32x4*)(SSQ + (size_t)row * 16 + 4), s2 = *(const f32x4*)(SSQ + (size_t)row * 16 + 8), s3 = *(const f32x4*)(SSQ + (size_t)row * 16 + 12);
    const float ss = (((s0[0] + s0[1]) + (s0[2] + s0[3])) + ((s1[0] + s1[1]) + (s1[2] + s1[3]))) + (((s2[0] + s2[1]) + (s2[2] + s2[3])) + ((s3[0] + s3[1]) + (s3[2] + s3[3])));
    return __builtin_amdgcn_rsqf(ss * (1.f / 1024.f) + 1e-6f);
}
struct EpiFF1 {
    static constexpr bool PERM = true, AFTER_DRAIN = false, HEADMAP = false;
    bf16_t* F; int ldc;
    __device__ __forceinline__ void operator()(const f32x4 (&acc)[2][2][4][2], const Unit& u, int wr, int wc, int fr, int fq) const {
        const int row0 = u.pm * BM + wr * 64 + fr, col0 = u.pn * BM + wc * 32 + 8 * fq;
#pragma unroll
        for (int ai = 0; ai < 2; ++ai)
#pragma unroll
            for (int m = 0; m < 4; ++m) { const int row = row0 + ai * HALF + m * 16;
#pragma unroll
                for (int bj = 0; bj < 2; ++bj) { EP_X8(x, acc[ai][bj][m][0], acc[ai][bj][m][1]);
#pragma unroll
                    for (int e = 0; e < 8; ++e) { const float t = fmaxf(x[e], 0.f); x[e] = t * t; }
                    *(u32x4*)(F + (size_t)row * ldc + col0 + bj * HALF) = ep_pack8(x); }
                asm volatile("" ::: "memory"); }
    }
};
struct EpiFinal {
    static constexpr bool PERM = true, AFTER_DRAIN = false, HEADMAP = false;
    float* y; const bf16_t* X2; const bf16_t* PJ; const float* SSQ;
    __device__ __forceinline__ void operator()(const f32x4 (&acc)[2][2][4][2], const Unit& u, int wr, int wc, int fr, int fq) const {
        const int row0 = u.pm * BM + wr * 64 + fr, col0 = u.pn * BM + wc * 32 + 8 * fq;
#pragma unroll
        for (int ai = 0; ai < 2; ++ai)
#pragma unroll
            for (int m = 0; m < 4; ++m) { const int row = row0 + ai * HALF + m * 16; const float r = ep_rstd16(SSQ, row);
#pragma unroll
                for (int bj = 0; bj < 2; ++bj) { EP_X8(x, acc[ai][bj][m][0], acc[ai][bj][m][1]); const size_t o = (size_t)row * 1024 + col0 + bj * HALF;
                    float pj[8], xo[8]; ep_unpack8(*(const u32x4*)(PJ + o), pj); ep_unpack8(*(const u32x4*)(X2 + o), xo);
#pragma unroll
                    for (int e = 0; e < 8; ++e) x[e] = xo[e] + ep_sigmoid(x[e] * r) * pj[e];
                    __builtin_nontemporal_store((f32x4){x[0], x[1], x[2], x[3]}, (f32x4*)(y + o)); __builtin_nontemporal_store((f32x4){x[4], x[5], x[6], x[7]}, (f32x4*)(y + o + 4)); }
                asm volatile("" ::: "memory"); }
    }
};

constexpr long KVC_TOTAL = 64L * 128 * 1536;
template <int N> struct KvBatch {
    const float* c2; float* out; long lim;
    f32x4 v[N];
    __device__ __forceinline__ bool addr(long i, const f32x4*& s, f32x4*& d) const {
        if (i >= lim) return false;
        const unsigned u = (unsigned)i, seg = u / 196608u, rem = u - seg * 196608u, blk = rem / 1536u, off = rem - blk * 1536u;
        const size_t e = (size_t)seg * (2048 * 128) + (size_t)(16 * blk + 4) * 128 + off;
        s = (const f32x4*)c2 + e; d = (f32x4*)(out + O_KV2048S) + e - 512; return true;
    }
    __device__ __forceinline__ void load(long e0, int tid) {
#pragma unroll
        for (int k = 0; k < N; ++k) { const f32x4* s; f32x4* d; if (addr(e0 + 512 * k + tid, s, d)) v[k] = __builtin_nontemporal_load(s); }
    }
    __device__ __forceinline__ void store(long e0, int tid) {
        asm volatile("" : "+v"(tid));
#pragma unroll
        for (int k = 0; k < N; ++k) { const f32x4* s; f32x4* d; if (addr(e0 + 512 * k + tid, s, d)) __builtin_nontemporal_store(v[k], d); }
    }
};
constexpr int KVC_BN = 14, KVC_GN = 0;
constexpr long KVC_E_GEMM = KVC_TOTAL - 4480L * 512 * KVC_GN;
static_assert(KVC_E_GEMM >= 0 && 8L * 256 * 448 * KVC_BN >= KVC_E_GEMM, "the copy does not fit its hosts");
struct KvCopy {
    KvBatch<KVC_GN> b; int base;
    __device__ __forceinline__ void load(const Unit& u, int tid) { b.load(KVC_E_GEMM + (long)(base + u.L) * (512 * KVC_GN), tid); }
    __device__ __forceinline__ void store(const Unit& u, int tid) { b.store(KVC_E_GEMM + (long)(base + u.L) * (512 * KVC_GN), tid); }
};

struct NoCopy { __device__ __forceinline__ void load(const Unit&, int) {} __device__ __forceinline__ void store(const Unit&, int) {} };
template <class Epi, class Sched, bool ALIGN_EPI = false, bool SP2 = false, class CP = NoCopy>
__device__ __forceinline__ void gemm_phase(PG8_LAS unsigned char* lds, const Gemm g, const Sched& S, const Epi& E, CP cp = CP()) {
    int tid_ = threadIdx.x; asm volatile("" : "+v"(tid_));
    const int tid = tid_, wid = __builtin_amdgcn_readfirstlane(tid >> 6), lane = tid & 63, wr = wid >> 2, wc = wid & 3, fr = lane & 15, fq = lane >> 4;
    const int K = g.K, nt = K / BK;
    unsigned voffA[2], voffB[2];
#pragma unroll
    for (int i = 0; i < 2; ++i) { int R, C; stage_rc(tid * 16 + i * 8192, R, C); const int Rb = Epi::HEADMAP ? (64 * (R >> 5) + perm32(R & 31)) : (Epi::PERM ? ((R & ~31) + perm32(R & 31)) : R);
        voffA[i] = (unsigned)(R * K + C) * 2u; voffB[i] = (unsigned)(Rb * K + C) * 2u; }
    const size_t kstep = (size_t)(BK * 2);
    const size_t hstep = (size_t)HALF * K * 2;
    const size_t tstep = 2 * hstep;
    const size_t hstepB = Epi::HEADMAP ? (size_t)32 * K * 2 : hstep;
    const unsigned ldsw = (unsigned)wid * 1024u;
    const int aoff = lds_byte(wr * 64 + fr, fq * 8), boff = lds_byte(wc * 32 + fr, fq * 8);
#define PG8_SA(b, h) (((b) * 2 + (h)) * HTB)
#define PG8_SB(b, h) ((4 + (b) * 2 + (h)) * HTB)
#define PG8_STAGE(bufoff, gbase, voff) do { _Pragma("unroll") for (int _i = 0; _i < 2; ++_i) \
        __builtin_amdgcn_global_load_lds((const unsigned*)((const char*)(gbase) + (voff)[_i]), (PG8_LAS unsigned*)(lds + (bufoff) + ldsw + _i * 8192), 16, 0, 0); } while (0)
#define PG8_LDA(dst, b, h) do { _Pragma("unroll") for (int m = 0; m < 4; ++m) _Pragma("unroll") for (int k = 0; k < 2; ++k) dst[m][k] = *(const PG8_LAS bf16x8*)(lds + PG8_SA(b, h) + aoff + m * 2048 + k * 1024); } while (0)
#define PG8_LDB(dst, b, h) do { _Pragma("unroll") for (int n = 0; n < 2; ++n) _Pragma("unroll") for (int k = 0; k < 2; ++k) dst[n][k] = *(const PG8_LAS bf16x8*)(lds + PG8_SB(b, h) + boff + n * 2048 + k * 1024); } while (0)
#define PG8_MMA(ai, bj, At, Bt) do { __builtin_amdgcn_s_setprio(1); _Pragma("unroll") for (int m = 0; m < 4; ++m) _Pragma("unroll") for (int n = 0; n < 2; ++n) _Pragma("unroll") for (int k = 0; k < 2; ++k) \
        acc[ai][bj][m][n] = __builtin_amdgcn_mfma_f32_16x16x32_bf16(Bt[n][k], At[m][k], acc[ai][bj][m][n], 0, 0, 0); __builtin_amdgcn_s_setprio(0); } while (0)
#define PG8_WAIT_V(n) asm volatile("s_waitcnt vmcnt(" #n ")" ::: "memory")
#define PG8_WAIT_L(n) asm volatile("s_waitcnt lgkmcnt(" #n ")" ::: "memory")
#define PG8_BAR __builtin_amdgcn_s_barrier()
#define PG8_SCHED __builtin_amdgcn_sched_barrier(0)
    Unit cur, nxt; int ui = 0;
    if (!S.next(0, cur)) return;
    f32x4 acc[2][2][4][2];
#pragma unroll
    for (int a = 0; a < 2; ++a)
#pragma unroll
        for (int b = 0; b < 2; ++b)
#pragma unroll
            for (int m = 0; m < 4; ++m)
#pragma unroll
                for (int n = 0; n < 2; ++n) acc[a][b][m][n] = (f32x4){0.f, 0.f, 0.f, 0.f};
    bf16x8 At[4][2], B0[2][2], B1[2][2];
    const char* cA = (const char*)g.A + (size_t)cur.pm * tstep; const char* cB = (const char*)g.Bt + (size_t)cur.pn * tstep;
    S.a_ready(cur);
    if constexpr (SP2) {
        PG8_STAGE(PG8_SB(0, 0), cB, voffB); PG8_STAGE(PG8_SB(0, 1), cB + hstepB, voffB); PG8_STAGE(PG8_SA(0, 0), cA, voffA); PG8_STAGE(PG8_SA(0, 1), cA + hstep, voffA);
        if (wr == 1) PG8_BAR;
        PG8_WAIT_V(2); PG8_BAR;
        PG8_STAGE(PG8_SB(1, 0), cB + kstep, voffB); PG8_STAGE(PG8_SA(1, 0), cA + kstep, voffA); PG8_STAGE(PG8_SB(1, 1), cB + hstepB + kstep, voffB);
        PG8_WAIT_V(6); PG8_BAR;
    } else {
        PG8_STAGE(PG8_SB(0, 0), cB, voffB); PG8_STAGE(PG8_SA(0, 0), cA, voffA); PG8_STAGE(PG8_SB(0, 1), cB + hstepB, voffB); PG8_STAGE(PG8_SA(0, 1), cA + hstep, voffA);
        if (wr == 1) PG8_BAR;
        PG8_WAIT_V(4); PG8_BAR;
        PG8_STAGE(PG8_SB(1, 0), cB + kstep, voffB); PG8_STAGE(PG8_SA(1, 0), cA + kstep, voffA); PG8_STAGE(PG8_SB(1, 1), cB + hstepB + kstep, voffB);
        PG8_WAIT_V(6); PG8_BAR;
    }
    for (;;) {
        const bool has_next = S.next(ui + 1, nxt);
        const char* nA = has_next ? (const char*)g.A + (size_t)nxt.pm * tstep : cA; const char* nB = has_next ? (const char*)g.Bt + (size_t)nxt.pn * tstep : cB;
#pragma unroll 1
        for (int t = 0; t < nt; t += 2) {
            const bool last = (t == nt - 2);
            const char* a1 = cA + (size_t)(t + 1) * kstep;
            const char* a2 = last ? nA : cA + (size_t)(t + 2) * kstep; const char* b2 = last ? nB : cB + (size_t)(t + 2) * kstep;
            const char* a3 = a2 + kstep; const char* b3 = b2 + kstep;
            if (last && has_next) S.a_ready(nxt);
            if constexpr (SP2) {
            PG8_LDB(B0, 0, 0); PG8_LDB(B1, 0, 1); PG8_SCHED; PG8_LDA(At, 0, 0); PG8_STAGE(PG8_SA(1, 1), a1 + hstep, voffA);
            PG8_WAIT_V(8); PG8_WAIT_L(0); PG8_BAR; PG8_MMA(0, 0, At, B0); PG8_MMA(0, 1, At, B1); PG8_BAR; PG8_SCHED;
            PG8_LDA(At, 0, 1); PG8_STAGE(PG8_SB(0, 0), b2, voffB); PG8_STAGE(PG8_SB(0, 1), b2 + hstepB, voffB); PG8_STAGE(PG8_SA(0, 0), a2, voffA);
            PG8_WAIT_V(8); PG8_WAIT_L(0); PG8_BAR; PG8_MMA(1, 0, At, B0); PG8_MMA(1, 1, At, B1); PG8_BAR; PG8_SCHED;
            PG8_LDB(B0, 1, 0); PG8_LDB(B1, 1, 1); PG8_SCHED; PG8_LDA(At, 1, 0); PG8_STAGE(PG8_SA(0, 1), a2 + hstep, voffA);
            PG8_WAIT_V(8); PG8_WAIT_L(0); PG8_BAR; PG8_MMA(0, 0, At, B0); PG8_MMA(0, 1, At, B1); PG8_BAR; PG8_SCHED;
            PG8_LDA(At, 1, 1); PG8_STAGE(PG8_SB(1, 0), b3, voffB); PG8_STAGE(PG8_SB(1, 1), b3 + hstepB, voffB); PG8_STAGE(PG8_SA(1, 0), a3, voffA);
            PG8_WAIT_V(8); PG8_WAIT_L(0); PG8_BAR; PG8_MMA(1, 0, At, B0); PG8_MMA(1, 1, At, B1); PG8_BAR; PG8_SCHED;
            } else {
            PG8_LDB(B0, 0, 0); PG8_SCHED; PG8_LDA(At, 0, 0); PG8_STAGE(PG8_SA(1, 1), a1 + hstep, voffA);
            PG8_WAIT_L(8); PG8_BAR; PG8_WAIT_L(0); PG8_MMA(0, 0, At, B0); PG8_BAR; PG8_SCHED;
            PG8_LDB(B1, 0, 1); PG8_STAGE(PG8_SB(0, 0), b2, voffB);
            PG8_BAR; PG8_WAIT_L(0); PG8_MMA(0, 1, At, B1); PG8_BAR;
            PG8_LDA(At, 0, 1); PG8_STAGE(PG8_SA(0, 0), a2, voffA);
            PG8_BAR; PG8_WAIT_L(0); PG8_MMA(1, 0, At, B0); PG8_BAR; PG8_SCHED;
            PG8_STAGE(PG8_SB(0, 1), b2 + hstepB, voffB);
            PG8_WAIT_V(6); PG8_BAR; PG8_MMA(1, 1, At, B1); PG8_BAR;
            PG8_LDB(B0, 1, 0); PG8_SCHED; PG8_LDA(At, 1, 0); PG8_STAGE(PG8_SA(0, 1), a2 + hstep, voffA);
            PG8_WAIT_L(8); PG8_BAR; PG8_WAIT_L(0); PG8_MMA(0, 0, At, B0); PG8_BAR; PG8_SCHED;
            PG8_LDB(B1, 1, 1); PG8_STAGE(PG8_SB(1, 0), b3, voffB);
            PG8_BAR; PG8_WAIT_L(0); PG8_MMA(0, 1, At, B1); PG8_BAR;
            PG8_LDA(At, 1, 1); PG8_STAGE(PG8_SA(1, 0), a3, voffA);
            PG8_BAR; PG8_WAIT_L(0); PG8_MMA(1, 0, At, B0); PG8_BAR; PG8_SCHED;
            PG8_STAGE(PG8_SB(1, 1), b3 + hstepB, voffB);
            PG8_WAIT_V(6); PG8_BAR; PG8_MMA(1, 1, At, B1); PG8_BAR;
            }
        }
        if constexpr (ALIGN_EPI) { if (wr == 0) PG8_BAR; }
        if constexpr (!Epi::AFTER_DRAIN) { cp.load(cur, tid); E(acc, cur, wr, wc, fr, fq); cp.store(cur, tid); S.done(cur); }
        if (!has_next) break;
#pragma unroll
        for (int a = 0; a < 2; ++a)
#pragma unroll
            for (int b = 0; b < 2; ++b)
#pragma unroll
                for (int m = 0; m < 4; ++m)
#pragma unroll
                    for (int n = 0; n < 2; ++n) acc[a][b][m][n] = (f32x4){0.f, 0.f, 0.f, 0.f};
        cur = nxt; cA = nA; cB = nB; ++ui;
        if constexpr (ALIGN_EPI) { if (wr == 1) PG8_BAR; }
    }
    PG8_WAIT_V(0);
    if constexpr (!ALIGN_EPI) { if (wr == 0) PG8_BAR; }
    PG8_BAR;
    if constexpr (Epi::AFTER_DRAIN) { E.fused(acc, cur, wr, wc, fr, fq, lds, wid, lane); S.done(cur); }
#undef PG8_SA
#undef PG8_SB
#undef PG8_STAGE
#undef PG8_LDA
#undef PG8_LDB
#undef PG8_MMA
#undef PG8_WAIT_V
#undef PG8_WAIT_L
#undef PG8_BAR
#undef PG8_SCHED
}
}
namespace sg {
typedef short bf16x8 __attribute__((ext_vector_type(8)));
typedef float f32x4 __attribute__((ext_vector_type(4)));
typedef unsigned u32x2 __attribute__((ext_vector_type(2)));
typedef unsigned u32x4 __attribute__((ext_vector_type(4)));
typedef __bf16 bf16x2 __attribute__((ext_vector_type(2)));
typedef float f32x2 __attribute__((ext_vector_type(2)));
__device__ __forceinline__ unsigned cvt2(float lo, float hi) { f32x2 v = {lo, hi}; bf16x2 b = __builtin_convertvector(v, bf16x2); return __builtin_bit_cast(unsigned, b); }
__device__ __forceinline__ float blo(unsigned w) { return __builtin_bit_cast(float, w << 16); }
__device__ __forceinline__ float bhi(unsigned w) { return __builtin_bit_cast(float, w & 0xffff0000u); }
__device__ __forceinline__ float sigm(float x) { return __builtin_amdgcn_rcpf(1.0f + __builtin_amdgcn_exp2f(-1.4426950408889634f * x)); }
__device__ __forceinline__ float gelu(float x) { const float y = 0.7978845608028654f * (x + 0.044715f * x * x * x); return x * sigm(2.0f * y); }

template <int NT, bool AF32, int UN = 4>
__device__ __forceinline__ void core(f32x4 (&acc)[NT], float& ss, const void* A, int lda, int row, const unsigned short* Wt, int ldw, int col0, int k0, int klen, int lane) {
    const int tok = lane & 15, fq = lane >> 4;
    const unsigned short* wp = Wt + (size_t)(col0 + tok) * ldw + k0 + 8 * fq;
    const unsigned short* a16 = (const unsigned short*)A + (size_t)row * lda + k0 + 8 * fq;
    const float* a32 = (const float*)A + (size_t)row * lda + k0 + 8 * fq;
#pragma unroll UN
    for (int k = 0; k < klen; k += 32) {
        bf16x8 af;
        if (AF32) { const f32x4 x0 = *(const f32x4*)(a32 + k), x1 = *(const f32x4*)(a32 + k + 4);
            ss += (x0[0] * x0[0] + x0[1] * x0[1]) + (x0[2] * x0[2] + x0[3] * x0[3]) + (x1[0] * x1[0] + x1[1] * x1[1]) + (x1[2] * x1[2] + x1[3] * x1[3]);
            af = __builtin_bit_cast(bf16x8, (u32x4){cvt2(x0[0], x0[1]), cvt2(x0[2], x0[3]), cvt2(x1[0], x1[1]), cvt2(x1[2], x1[3])}); }
        else af = *(const bf16x8*)(a16 + k);
#pragma unroll
        for (int nt = 0; nt < NT; ++nt) { const bf16x8 bf = *(const bf16x8*)(wp + (size_t)(16 * nt) * ldw + k);
            acc[nt] = __builtin_amdgcn_mfma_f32_16x16x32_bf16(bf, af, acc[nt], 0, 0, 0); }
    }
}
template <bool AF32, int STEPS>
__device__ __forceinline__ void core8(f32x4& out, float& ssout, __attribute__((address_space(3))) float* red, const void* A, int lda, int row0, const unsigned short* Wt, int ldw, int col0, int k0, int lane, int w) {
    const int tok = lane & 15, fq = lane >> 4, kw = k0 + 32 * STEPS * w + 8 * fq;
    bf16x8 af[2][STEPS], bfr[4][STEPS]; float ss[2] = {0.f, 0.f};
    if (AF32) {
        f32x4 x[2][STEPS][2];
#pragma unroll
        for (int rt = 0; rt < 2; ++rt)
#pragma unroll
            for (int s = 0; s < STEPS; ++s) { const float* p = (const float*)A + (size_t)(row0 + 16 * rt + tok) * lda + kw + 32 * s; x[rt][s][0] = *(const f32x4*)p; x[rt][s][1] = *(const f32x4*)(p + 4); }
#pragma unroll
        for (int ct = 0; ct < 4; ++ct)
#pragma unroll
            for (int s = 0; s < STEPS; ++s) bfr[ct][s] = *(const bf16x8*)(Wt + (size_t)(col0 + 16 * ct + tok) * ldw + kw + 32 * s);
#pragma unroll
        for (int rt = 0; rt < 2; ++rt)
#pragma unroll
            for (int s = 0; s < STEPS; ++s) { const f32x4 x0 = x[rt][s][0], x1 = x[rt][s][1];
                ss[rt] += (x0[0] * x0[0] + x0[1] * x0[1]) + (x0[2] * x0[2] + x0[3] * x0[3]) + (x1[0] * x1[0] + x1[1] * x1[1]) + (x1[2] * x1[2] + x1[3] * x1[3]);
                af[rt][s] = __builtin_bit_cast(bf16x8, (u32x4){cvt2(x0[0], x0[1]), cvt2(x0[2], x0[3]), cvt2(x1[0], x1[1]), cvt2(x1[2], x1[3])}); }
    } else {
#pragma unroll
        for (int rt = 0; rt < 2; ++rt)
#pragma unroll
            for (int s = 0; s < STEPS; ++s) af[rt][s] = *(const bf16x8*)((const unsigned short*)A + (size_t)(row0 + 16 * rt + tok) * lda + kw + 32 * s);
#pragma unroll
        for (int ct = 0; ct < 4; ++ct)
#pragma unroll
            for (int s = 0; s < STEPS; ++s) bfr[ct][s] = *(const bf16x8*)(Wt + (size_t)(col0 + 16 * ct + tok) * ldw + kw + 32 * s);
    }
#pragma unroll
    for (int rt = 0; rt < 2; ++rt)
#pragma unroll
        for (int ct = 0; ct < 4; ++ct) { f32x4 acc = (f32x4){0.f, 0.f, 0.f, 0.f};
#pragma unroll
            for (int s = 0; s < STEPS; ++s) acc = __builtin_amdgcn_mfma_f32_16x16x32_bf16(bfr[ct][s], af[rt][s], acc, 0, 0, 0);
            *(__attribute__((address_space(3))) f32x4*)(red + ((w * 8 + rt * 4 + ct) * 64 + lane) * 4) = acc; }
    if (AF32) {
#pragma unroll
        for (int rt = 0; rt < 2; ++rt) { float v = ss[rt]; v += __shfl_xor(v, 16); v += __shfl_xor(v, 32); if (fq == 0) red[16384 + w * 32 + rt * 16 + tok] = v; }
    }
    __syncthreads();
    f32x4 o = (f32x4){0.f, 0.f, 0.f, 0.f}; float so = 0.f;
#pragma unroll
    for (int w2 = 0; w2 < 8; ++w2) { o += *(const __attribute__((address_space(3))) f32x4*)(red + ((w2 * 8 + w) * 64 + lane) * 4); if (AF32) so += red[16384 + w2 * 32 + (w >> 2) * 16 + tok]; }
    out = o; ssout = so;
    __syncthreads();
}
}


#define GAS __attribute__((address_space(1)))
#define LAS __attribute__((address_space(3)))
typedef unsigned short bf16;
typedef unsigned v4u __attribute__((ext_vector_type(4)));
typedef unsigned v2u __attribute__((ext_vector_type(2)));
typedef float f32x4 __attribute__((ext_vector_type(4)));
#define LDS_WAIT() asm volatile("s_waitcnt lgkmcnt(0)" ::: "memory")
#define VM_WAIT() asm volatile("s_waitcnt vmcnt(0)" ::: "memory")
__device__ __forceinline__ unsigned f2bf(float f) { unsigned u = __builtin_bit_cast(unsigned, f); return (u + 0x7fffu + ((u >> 16) & 1u)) >> 16; }
__device__ __forceinline__ unsigned pk2(float lo, float hi) { return f2bf(lo) | (f2bf(hi) << 16); }
__device__ __forceinline__ float bf2f(unsigned short b) { return __builtin_bit_cast(float, (unsigned)b << 16); }
__device__ __forceinline__ float bflo(unsigned w) { return __builtin_bit_cast(float, w << 16); }
__device__ __forceinline__ float bfhi(unsigned w) { return __builtin_bit_cast(float, w & 0xffff0000u); }

#define XB_TMO      128
#define XB_XCNT(j)  (256  + 64 * (j))
#define XB_XSUB(j)  (1280 + 64 * (j))
#define XB_XGEN(j)  (2304 + 64 * (j))
#define XB_TOP      3328
#define XB_TOPGEN   3392
#define XCD_BAR_WORDS 3456
#define XB_SPIN_CAP (1u << 18)

__device__ __forceinline__ unsigned xb_ld(unsigned* p)              { return __hip_atomic_load(p, __ATOMIC_RELAXED, __HIP_MEMORY_SCOPE_AGENT); }
__device__ __forceinline__ unsigned xb_add(unsigned* p, unsigned v) { return __hip_atomic_fetch_add(p, v, __ATOMIC_RELAXED, __HIP_MEMORY_SCOPE_AGENT); }
__device__ __forceinline__ unsigned xb_xcc_id() { return (unsigned)__builtin_amdgcn_s_getreg((3 << 11) | 20) & 0xFu; }
#define XB_SPIN(cond, bar) do { unsigned _sp = 0; while (cond) { __builtin_amdgcn_s_sleep(1); \
    if ((++_sp & 255u) == 0u) { if (xb_ld(&(bar)[XB_TMO])) break; if (_sp > XB_SPIN_CAP) { atomicAdd(&(bar)[XB_TMO], 1u); break; } } } } while (0)

struct XcdBarrier {
    unsigned* bar; unsigned x;
    volatile LAS unsigned* st;
};

__device__ __forceinline__ XcdBarrier xcd_barrier_post(unsigned* bar, volatile LAS unsigned* st) {
    XcdBarrier b; b.bar = bar; b.x = xb_xcc_id(); b.st = st;
    if (threadIdx.x == 0) (void)xb_add(&bar[XB_XCNT(b.x)], 1u);
    return b;
}
__device__ __forceinline__ void xcd_barrier_complete(unsigned* bar, unsigned x, unsigned& nloc, unsigned& nx) {
    const unsigned G = gridDim.x * gridDim.y * gridDim.z;
    unsigned sum, cnt, mine, sp = 0u;
    for (;;) {
        sum = 0u; cnt = 0u; mine = 0u;
#pragma unroll
        for (unsigned j = 0; j < 16; ++j) { const unsigned c = xb_ld(&bar[XB_XCNT(j)]); sum += c; cnt += (c > 0u) ? 1u : 0u; mine = (j == x) ? c : mine; }
        if (sum == G) break;
        __builtin_amdgcn_s_sleep(1);
        if ((++sp & 255u) == 0u) { if (xb_ld(&bar[XB_TMO])) break; if (sp > XB_SPIN_CAP) { atomicAdd(&bar[XB_TMO], 1u); break; } }
    }
    nloc = mine > 0u ? mine : 1u; nx = cnt > 0u ? cnt : 1u;
}

template <int BN> __device__ __forceinline__ void xcd_barrier(const XcdBarrier& b, const float* kvc, float* kvo, long e0) {
    pg8::KvBatch<BN> kb{kvc, kvo, pg8::KVC_E_GEMM, {}}; const long eb = e0 + (long)threadIdx.x - 64;
    asm volatile("s_waitcnt vmcnt(0)" ::: "memory");
    __syncthreads();
    if (threadIdx.x >= 64) {
#pragma unroll
        for (int k = 0; k < BN; ++k) { const f32x4* sp; f32x4* dp; if (kb.addr(eb + 448 * k, sp, dp)) kb.v[k] = __builtin_nontemporal_load(sp); }
#pragma unroll
        for (int k = 0; k < BN; ++k) { const f32x4* sp; f32x4* dp; if (kb.addr(eb + 448 * k, sp, dp)) __builtin_nontemporal_store(kb.v[k], dp); }
    }
    if (threadIdx.x == 0) {
        unsigned* bar = b.bar;
        __builtin_amdgcn_s_waitcnt(0);
        unsigned nloc = b.st[0], nx = b.st[1];
        if (nloc == 0u) { xcd_barrier_complete(bar, b.x, nloc, nx); b.st[0] = nloc; b.st[1] = nx; }
        const unsigned old = xb_add(&bar[XB_XSUB(b.x)], 1u);
        const unsigned gen = old / nloc;
        if (old + 1u == (gen + 1u) * nloc) {
            __builtin_amdgcn_fence(__ATOMIC_RELEASE, "agent");
            asm volatile("s_waitcnt vmcnt(0)" ::: "memory");
            const unsigned og = xb_add(&bar[XB_TOP], 1u);
            const unsigned tg = og / nx;
            if (og + 1u == (tg + 1u) * nx) xb_add(&bar[XB_TOPGEN], 1u);
            else XB_SPIN(xb_ld(&bar[XB_TOPGEN]) == tg, bar);
            __builtin_amdgcn_fence(__ATOMIC_ACQUIRE, "agent");
            xb_add(&bar[XB_XGEN(b.x)], 1u);
            asm volatile("s_waitcnt vmcnt(0)" ::: "memory");
        } else {
            XB_SPIN(xb_ld(&bar[XB_XGEN(b.x)]) == gen, bar);
            __builtin_amdgcn_fence(__ATOMIC_ACQUIRE, "agent");
            asm volatile("s_waitcnt vmcnt(0)" ::: "memory");
        }
    }
    __syncthreads();
}

__device__ __forceinline__ float wave_sum(float v) {
#pragma unroll
    for (int o = 1; o < 64; o <<= 1) v += __shfl_xor(v, o);
    return v;
}
__device__ __forceinline__ float wave_max(float v) {
#pragma unroll
    for (int o = 1; o < 64; o <<= 1) v = fmaxf(v, __shfl_xor(v, o));
    return v;
}
__device__ __forceinline__ float sigmoidf_(float x) { return __builtin_amdgcn_rcpf(1.0f + __builtin_amdgcn_exp2f(-1.4426950408889634f * x)); }
__device__ __forceinline__ float gelu_tanh(float x) { const float y = 0.7978845608028654f * (x + 0.044715f * x * x * x); return x * sigmoidf_(2.0f * y); }

__device__ __forceinline__ void p0_transpose_item(const float* W, int K, int N, bf16* WT, int row_off, LAS float* scr, int item, int lane, const float* gk = nullptr) {
    const int nblk = N / 32, kb = item / nblk, nb = item % nblk, k0 = 64 * kb, n0 = 32 * nb;
    { const int r8 = lane >> 3, c4 = lane & 7;
      f32x4 w[8]; float g[8];
#pragma unroll
      for (int i = 0; i < 8; ++i) { const int kk = 8 * i + r8; w[i] = __builtin_nontemporal_load((const GAS f32x4*)(W + (size_t)(k0 + kk) * N + n0) + c4); g[i] = gk ? gk[k0 + kk] : 1.0f; }
#pragma unroll
      for (int i = 0; i < 8; ++i) { LAS float* d = scr + (8 * i + r8) * 33 + 4 * c4; d[0] = w[i].x * g[i]; d[1] = w[i].y * g[i]; d[2] = w[i].z * g[i]; d[3] = w[i].w * g[i]; } }
    LDS_WAIT(); asm volatile("" ::: "memory");
    const int c = lane & 7;
#pragma unroll
    for (int j = 0; j < 4; ++j) { const int n = (lane >> 3) + 8 * j; const LAS float* s = scr + (8 * c) * 33 + n;
        v4u o; o.x = pk2(s[0 * 33], s[1 * 33]); o.y = pk2(s[2 * 33], s[3 * 33]); o.z = pk2(s[4 * 33], s[5 * 33]); o.w = pk2(s[6 * 33], s[7 * 33]);
        *(GAS v4u*)(WT + (size_t)(row_off + n0 + n) * K + k0 + 8 * c) = o; }
    LDS_WAIT(); asm volatile("" ::: "memory");
}

struct Frame {
    LAS unsigned char* lds;
    int tid, lane, wave, vcu, G;
};

struct Args { const float* in[23]; float* out; unsigned char* ws; };

__device__ __forceinline__ void rot_cs(int pos, int i, float& c, float& s) {
    const float inv = exp2f(-(float)i * (18.931568569324174f / 8.0f));
    const float ang = (float)pos * inv;
    const double rev = (double)ang * 0.15915494309189535;
    const float fr = (float)(rev - floor(rev));
    s = __builtin_amdgcn_sinf(fr); c = __builtin_amdgcn_cosf(fr);
}

__device__ __forceinline__ void p0_prologue(const Frame& F, const Args& a) {
    unsigned char* ws = a.ws;
    LAS float* scr = (LAS float*)(F.lds + RING_OFF + F.wave * 16384);
    const int gw = F.vcu * NWAVES + F.wave, NGW = F.G * NWAVES;
    const int e0 = blockIdx.x * 512 + F.tid;
    float wsv = 0.f; f32x4 xsv = (f32x4){0.f, 0.f, 0.f, 0.f};
    if (e0 < 4 * 128 * 128) wsv = a.in[10][e0];
    if (e0 < M_SAMPLE * D / 4) xsv = ((const GAS f32x4*)a.in[1])[e0];
    {
        float* ROT = (float*)(ws + WS_ROT);
        for (int i = e0; i < 4100 * 8; i += F.G * 512) { const int idx = i >> 3, pos = idx < 4096 ? idx : PAST_LEN + (idx - 4096); float c, sn; rot_cs(pos, i & 7, c, sn); ROT[2 * i] = c; ROT[2 * i + 1] = sn; }
        float* MGS = (float*)(ws + WS_MGS);
        for (int i = e0; i < M_SAMPLE * D / 4; i += F.G * 512) ((GAS f32x4*)MGS)[i] = (f32x4){0.f, 0.f, 0.f, 0.f};
    }
    {
        constexpr int I_IN = (D / 64) * (D_IN / 32), I_OA = (D_A / 64) * (D / 32), I_OB = I_OA, I_O = (D / 64) * (D / 32), I_F1 = (D / 64) * (D_FF / 32), I_F2 = (D_FF / 64) * (D / 32), I_PG = I_O, I_PP = (D_PLE / 64) * (D / 32);
        constexpr int NITEMS = I_IN + I_OA + I_OB + I_O + I_F1 + I_F2 + I_PG + I_PP;
        const float* gm = a.in[7];
        bf16* H = (bf16*)(ws + WS_H); bf16* PE = (bf16*)(ws + WS_PE);
        int it = gw, m0 = gw;
        while (it < NITEMS || m0 < MV) {
            const bool rows = m0 < MV;
            const int m1 = (m0 + NGW < MV) ? m0 + NGW : m0;
            f32x4 v[2][4], p[2];
            if (rows) {
#pragma unroll
                for (int q = 0; q < 2; ++q) { const int m = q ? m1 : m0;
                    const float* xrow = (m < M_PROMPT) ? a.in[0] + (size_t)m * D : a.in[1] + (size_t)(m - M_PROMPT) * D;
                    const float* prow = (m < M_PROMPT) ? a.in[2] + (size_t)m * D_PLE : a.in[3] + (size_t)(m - M_PROMPT) * D_PLE;
#pragma unroll
                    for (int j = 0; j < 4; ++j) v[q][j] = __builtin_nontemporal_load((const GAS f32x4*)xrow + F.lane + 64 * j);
                    p[q] = __builtin_nontemporal_load((const GAS f32x4*)prow + F.lane); }
            }
            if (it < NITEMS) {
                int r = it;
                if (r < I_IN) p0_transpose_item(a.in[8], D, D_IN, (bf16*)(ws + WS_WIN), 0, scr, r, F.lane);
                else if ((r -= I_IN) < I_OA) p0_transpose_item(a.in[14], D_A, D, (bf16*)(ws + WS_WOA), 0, scr, r, F.lane);
                else if ((r -= I_OA) < I_OB) p0_transpose_item(a.in[15], D_A, D, (bf16*)(ws + WS_WOB), 0, scr, r, F.lane);
                else if ((r -= I_OB) < I_O) p0_transpose_item(a.in[16], D, D, (bf16*)(ws + WS_WO), 0, scr, r, F.lane);
                else if ((r -= I_O) < I_F1) p0_transpose_item(a.in[18], D, D_FF, (bf16*)(ws + WS_WFF1), 0, scr, r, F.lane, a.in[17]);
                else if ((r -= I_F1) < I_F2) p0_transpose_item(a.in[19], D_FF, D, (bf16*)(ws + WS_WFF2), 0, scr, r, F.lane);
                else if ((r -= I_F2) < I_PG) p0_transpose_item(a.in[21], D, D, (bf16*)(ws + WS_WPG), 0, scr, r, F.lane, a.in[20]);
                else { r -= I_PG; p0_transpose_item(a.in[22], D_PLE, D, (bf16*)(ws + WS_WPP), 0, scr, r, F.lane); }
                it += NGW;
            }
            if (rows) {
#pragma unroll
                for (int q = 0; q < 2; ++q) { const int m = q ? m1 : m0; float s = 0.f;
#pragma unroll
                    for (int j = 0; j < 4; ++j) s += (v[q][j].x * v[q][j].x + v[q][j].y * v[q][j].y) + (v[q][j].z * v[q][j].z + v[q][j].w * v[q][j].w);
                    const float r = __builtin_amdgcn_rsqf(wave_sum(s) * (1.f / D) + EPS);
                    GAS unsigned long long* o8 = (GAS unsigned long long*)(H + (size_t)m * D) + F.lane;
#pragma unroll
                    for (int j = 0; j < 4; ++j) { const f32x4 g = ((const GAS f32x4*)gm)[F.lane + 64 * j];
                        o8[64 * j] = (unsigned long long)pk2(v[q][j].x * r * g.x, v[q][j].y * r * g.y) | ((unsigned long long)pk2(v[q][j].z * r * g.z, v[q][j].w * r * g.w) << 32); }
                    ((GAS unsigned long long*)(PE + (size_t)m * D_PLE))[F.lane] = (unsigned long long)pk2(p[q].x, p[q].y) | ((unsigned long long)pk2(p[q].z, p[q].w) << 32); }
                m0 += 2 * NGW;
            }
        }
    }
    {
        const float* w_s = a.in[10]; bf16* WSB = (bf16*)(ws + WS_WSB);
        if (e0 < 4 * 128 * 128) { const int t = (e0 >> 7) & 127, sx = e0 & 127; WSB[e0] = (bf16)f2bf(sx <= t ? wsv : 0.f); }
        for (int i = e0 + F.G * 512; i < 4 * 128 * 128; i += F.G * 512) { const int t = (i >> 7) & 127, sx = i & 127; WSB[i] = (bf16)f2bf(sx <= t ? w_s[i] : 0.f); }
        float* X1S = (float*)(ws + WS_X1S); const float* xs = a.in[1];
        if (e0 < M_SAMPLE * D / 4) ((GAS f32x4*)X1S)[e0] = xsv;
        for (int i = e0 + F.G * 512; i < M_SAMPLE * D / 4; i += F.G * 512) ((GAS f32x4*)X1S)[i] = ((const GAS f32x4*)xs)[i];
    }
}

__device__ __forceinline__ int perm_row(int m, int g) {
    if (g == 0 || m >= M_PROMPT) return m;
    const int b = m >> 12, t = m & 4095, sh = (g == 1) ? 2 : 4;
    return (b << 12) + (t & ((1 << sh) - 1)) * (4096 >> sh) + (t >> sh);
}
typedef short bf16x8_t __attribute__((ext_vector_type(8)));
typedef short s16x4_t __attribute__((ext_vector_type(4)));
typedef float f32x16 __attribute__((ext_vector_type(16)));
typedef __bf16 bf16x2v __attribute__((ext_vector_type(2)));
typedef float f32x2v __attribute__((ext_vector_type(2)));
__device__ __forceinline__ unsigned cvtpk(float lo, float hi) { f32x2v v = {lo, hi}; bf16x2v b = __builtin_convertvector(v, bf16x2v); return __builtin_bit_cast(unsigned, b); }
__device__ __forceinline__ int crow(int r, int hi) { return (r & 3) + 8 * (r >> 2) + 4 * hi; }
__device__ __forceinline__ s16x4_t vtr(const LAS unsigned char* p) { return __builtin_bit_cast(s16x4_t, __builtin_amdgcn_ds_read_tr16_b64_v4i16((LAS s16x4_t*)p)); }

constexpr int AT_K = 0, AT_V = 49152, AT_OST = 98304, AT_WSF = 132096;
constexpr float SM_C2 = 0.125f * 1.4426950408889634f;

__device__ __forceinline__ void p3_swa(const Frame& F, const Args& a) {
    unsigned char* ws = a.ws;
    const bf16* Q = (const bf16*)(ws + WS_Q); const bf16* K = (const bf16*)(ws + WS_K); const bf16* V = (const bf16*)(ws + WS_V);
    bf16* OG = (bf16*)(ws + WS_OG); float* LSE = (float*)(ws + WS_LSE);
    const int tid = F.tid, lane = F.lane, w = F.wave, l31 = lane & 31, hi = lane >> 5;
    const LAS unsigned char* ldsK = F.lds + AT_K; const LAS unsigned char* ldsV = F.lds + AT_V;
    LAS float* wsf = (LAS float*)(F.lds + AT_WSF) + w * 64;
    LAS bf16* stg = (LAS bf16*)(F.lds + AT_OST) + w * 2048;
    for (int it = F.vcu; it < 1536; it += F.G) {
        const int g = it >> 9; int rem = it & 511;
        const int j = rem & 7; rem >>= 3; const int b = rem & 3; rem >>= 2;
        const int sh = (g == 0) ? 0 : (g == 1) ? 2 : 4, nqb = 16 >> sh, qb = rem % nqb, r = rem / nqb, Lg = 4096 >> sh;
        const int hh = g * 8 + j;
        const int seqbase = (b << 12) + r * Lg;
        const int k0 = qb * 256 - 128;
        {
            v4u kr[6], vr[6];
#pragma unroll
            for (int k = 0; k < 6; ++k) { const int cidx = tid + 512 * k, row = cidx >> 3, c = cidx & 7; int srow = k0 + row; srow = srow < 0 ? 0 : srow;
                const size_t off = (size_t)(seqbase + srow) * DQKV + hh * HD + c * 8;
                kr[k] = *(const GAS v4u*)(K + off); vr[k] = *(const GAS v4u*)(V + off); }
#pragma unroll
            for (int k = 0; k < 6; ++k) { const int cidx = tid + 512 * k, row = cidx >> 3, c = cidx & 7;
                *(LAS v4u*)(F.lds + AT_K + row * 128 + ((c ^ ((row >> 1) & 7)) << 4)) = kr[k];
                *(LAS v4u*)(F.lds + AT_V + (row >> 3) * 1024 + (c >> 2) * 512 + (row & 7) * 64 + (c & 3) * 16) = vr[k]; }
        }
        bf16x8_t qf[4];
        { const bf16* qp = Q + (size_t)(seqbase + qb * 256 + 32 * w + l31) * DQKV + hh * HD + 8 * hi;
#pragma unroll
          for (int ks = 0; ks < 4; ++ks) qf[ks] = *(const GAS bf16x8_t*)(qp + 16 * ks); }
        __syncthreads();
        f32x16 S[5];
#pragma unroll
        for (int kb = 0; kb < 5; ++kb) {
            S[kb] = (f32x16){0.f,0.f,0.f,0.f,0.f,0.f,0.f,0.f,0.f,0.f,0.f,0.f,0.f,0.f,0.f,0.f};
            const int krow = 32 * (w + kb) + l31;
#pragma unroll
            for (int ks = 0; ks < 4; ++ks) { const int c = 2 * ks + hi;
                const bf16x8_t af = *(const LAS bf16x8_t*)(ldsK + krow * 128 + ((c ^ ((l31 >> 1) & 7)) << 4));
                S[kb] = __builtin_amdgcn_mfma_f32_32x32x16_bf16(af, qf[ks], S[kb], 0, 0, 0); }
        }
        const float NEGB = -1e30f;
#pragma unroll
        for (int rr = 0; rr < 16; ++rr) { const int kl = crow(rr, hi); if (kl < l31) S[0][rr] = NEGB; if (kl > l31) S[4][rr] = NEGB; }
        if (qb == 0) {
#pragma unroll
            for (int kb = 0; kb < 4; ++kb) if (w + kb < 4) {
#pragma unroll
                for (int rr = 0; rr < 16; ++rr) S[kb][rr] = NEGB; }
        }
        float mx = NEGB;
#pragma unroll
        for (int kb = 0; kb < 5; ++kb)
#pragma unroll
            for (int rr = 0; rr < 16; ++rr) mx = fmaxf(mx, S[kb][rr]);
        { const unsigned xi = __builtin_bit_cast(unsigned, mx); const auto rr = __builtin_amdgcn_permlane32_swap(xi, xi, false, false); mx = fmaxf(__builtin_bit_cast(float, (unsigned)rr[0]), __builtin_bit_cast(float, (unsigned)rr[1])); }
        const float mc = mx * SM_C2; float lsum = 0.f;
#pragma unroll
        for (int kb = 0; kb < 5; ++kb)
#pragma unroll
            for (int rr = 0; rr < 16; ++rr) { const float p = __builtin_amdgcn_exp2f(S[kb][rr] * SM_C2 - mc); S[kb][rr] = p; lsum += p; }
        lsum = pg8::ep_sum_xor32(lsum);
        f32x16 O[2];
        O[0] = (f32x16){0.f,0.f,0.f,0.f,0.f,0.f,0.f,0.f,0.f,0.f,0.f,0.f,0.f,0.f,0.f,0.f}; O[1] = O[0];
        const int vbase = (4 * hi + ((lane & 15) >> 2)) * 64 + ((lane >> 4) & 1) * 32 + (lane & 3) * 8;
#pragma unroll
        for (int kb = 0; kb < 5; ++kb)
#pragma unroll
            for (int s = 0; s < 2; ++s) {
                v4u pw; pw.x = cvtpk(S[kb][8 * s + 0], S[kb][8 * s + 1]); pw.y = cvtpk(S[kb][8 * s + 2], S[kb][8 * s + 3]); pw.z = cvtpk(S[kb][8 * s + 4], S[kb][8 * s + 5]); pw.w = cvtpk(S[kb][8 * s + 6], S[kb][8 * s + 7]);
                const bf16x8_t pa = __builtin_bit_cast(bf16x8_t, pw);
                const int kg0 = 4 * (w + kb) + 2 * s;
#pragma unroll
                for (int nb = 0; nb < 2; ++nb) {
                    const s16x4_t lo = vtr(ldsV + kg0 * 1024 + nb * 512 + vbase), hv = vtr(ldsV + (kg0 + 1) * 1024 + nb * 512 + vbase);
                    const bf16x8_t vb = (bf16x8_t){lo[0], lo[1], lo[2], lo[3], hv[0], hv[1], hv[2], hv[3]};
                    O[nb] = __builtin_amdgcn_mfma_f32_32x32x16_bf16(pa, vb, O[nb], 0, 0, 0);
                }
            }
        if (hi == 0) wsf[l31] = lsum;
        LDS_WAIT(); asm volatile("" ::: "memory");
#pragma unroll
        for (int rr = 0; rr < 16; ++rr) { const int qr = crow(rr, hi); const float rl = __builtin_amdgcn_rcpf(wsf[qr]);
            stg[qr * 64 + l31] = (bf16)f2bf(O[0][rr] * rl); stg[qr * 64 + 32 + l31] = (bf16)f2bf(O[1][rr] * rl); }
        LDS_WAIT(); asm volatile("" ::: "memory");
        const int mq0 = (b << 12) + r, qi0 = qb * 256 + 32 * w;
#pragma unroll
        for (int i = 0; i < 4; ++i) { const int row = i * 8 + (lane >> 3), ch = lane & 7; const v4u v = *(const LAS v4u*)(stg + row * 64 + ch * 8);
            const int m = mq0 + ((qi0 + row) << sh);
            *(GAS v4u*)(OG + ((size_t)g * M_PROMPT + m) * 512 + j * HD + ch * 8) = v; }
        if (hi == 0) { const int m = mq0 + ((qi0 + l31) << sh); LSE[((size_t)g * M_PROMPT + m) * 8 + j] = mc + __builtin_amdgcn_logf(lsum); }
        __syncthreads();
    }
}

struct SaPass { v4u q0, q1; f32x4 k0, k1, k2, k3, v0, v1, v2, v3; };
__device__ __forceinline__ SaPass sa_load(int idx, const Args& a, const bf16* Q, const bf16* K, const bf16* V, int m, int j, int bs, int tl, int ksub, int part) {
    const int g = idx / 9, ps = idx - 9 * g, d = (g == 0) ? 1 : (g == 1) ? 4 : 16, W = 128 * d, h = g * 8 + j;
    const float* cache = (g == 0) ? a.in[4] : (g == 1) ? a.in[5] : a.in[6];
    SaPass P; const GAS v4u* qp = (const GAS v4u*)(Q + (size_t)m * DQKV + h * HD + 16 * part); P.q0 = qp[0]; P.q1 = qp[1];
    const int i = ps * 16 + ksub; const bool act = i <= 128; const int rel = tl - i * d;
    const f32x4 z4 = (f32x4){0.f, 0.f, 0.f, 0.f};
    P.k0 = z4; P.k1 = z4; P.k2 = z4; P.k3 = z4; P.v0 = z4; P.v1 = z4; P.v2 = z4; P.v3 = z4;
    if (act) {
        if (rel >= 0) { const size_t off = (size_t)(m - i * d) * DQKV + h * HD + 16 * part;
            P.k0 = ((const GAS f32x4*)(K + off))[0]; P.k1 = ((const GAS f32x4*)(K + off))[1]; P.v0 = ((const GAS f32x4*)(V + off))[0]; P.v1 = ((const GAS f32x4*)(V + off))[1]; }
        else { const size_t offk = ((((size_t)bs * 2 + 0) * W + (W + rel)) * 8 + j) * HD + 16 * part, offv = offk + (size_t)W * 8 * HD;
            const GAS f32x4* kp = (const GAS f32x4*)(cache + offk); const GAS f32x4* vp = (const GAS f32x4*)(cache + offv);
            P.k0 = kp[0]; P.k1 = kp[1]; P.k2 = kp[2]; P.k3 = kp[3]; P.v0 = vp[0]; P.v1 = vp[1]; P.v2 = vp[2]; P.v3 = vp[3]; }
    }
    return P;
}
__device__ __forceinline__ void sa_proc(const SaPass P, int idx, const Args& a, int j, int bs, int tl, int ksub, int part, float& mrun, float& sum, float (&o)[16]) {
    const int g = idx / 9, ps = idx - 9 * g, d = (g == 0) ? 1 : (g == 1) ? 4 : 16, W = 128 * d;
    const int i = ps * 16 + ksub; const bool act = i <= 128; const int rel = tl - i * d;
    float q[16], kx[16], vx[16];
    q[0] = bflo(P.q0.x); q[1] = bfhi(P.q0.x); q[2] = bflo(P.q0.y); q[3] = bfhi(P.q0.y); q[4] = bflo(P.q0.z); q[5] = bfhi(P.q0.z); q[6] = bflo(P.q0.w); q[7] = bfhi(P.q0.w);
    q[8] = bflo(P.q1.x); q[9] = bfhi(P.q1.x); q[10] = bflo(P.q1.y); q[11] = bfhi(P.q1.y); q[12] = bflo(P.q1.z); q[13] = bfhi(P.q1.z); q[14] = bflo(P.q1.w); q[15] = bfhi(P.q1.w);
    if (rel >= 0) {
        const v4u k0 = __builtin_bit_cast(v4u, P.k0), k1 = __builtin_bit_cast(v4u, P.k1), v0 = __builtin_bit_cast(v4u, P.v0), v1 = __builtin_bit_cast(v4u, P.v1);
        kx[0] = bflo(k0.x); kx[1] = bfhi(k0.x); kx[2] = bflo(k0.y); kx[3] = bfhi(k0.y); kx[4] = bflo(k0.z); kx[5] = bfhi(k0.z); kx[6] = bflo(k0.w); kx[7] = bfhi(k0.w);
        kx[8] = bflo(k1.x); kx[9] = bfhi(k1.x); kx[10] = bflo(k1.y); kx[11] = bfhi(k1.y); kx[12] = bflo(k1.z); kx[13] = bfhi(k1.z); kx[14] = bflo(k1.w); kx[15] = bfhi(k1.w);
        vx[0] = bflo(v0.x); vx[1] = bfhi(v0.x); vx[2] = bflo(v0.y); vx[3] = bfhi(v0.y); vx[4] = bflo(v0.z); vx[5] = bfhi(v0.z); vx[6] = bflo(v0.w); vx[7] = bfhi(v0.w);
        vx[8] = bflo(v1.x); vx[9] = bfhi(v1.x); vx[10] = bflo(v1.y); vx[11] = bfhi(v1.y); vx[12] = bflo(v1.z); vx[13] = bfhi(v1.z); vx[14] = bflo(v1.w); vx[15] = bfhi(v1.w);
    } else {
        kx[0] = P.k0.x; kx[1] = P.k0.y; kx[2] = P.k0.z; kx[3] = P.k0.w; kx[4] = P.k1.x; kx[5] = P.k1.y; kx[6] = P.k1.z; kx[7] = P.k1.w;
        kx[8] = P.k2.x; kx[9] = P.k2.y; kx[10] = P.k2.z; kx[11] = P.k2.w; kx[12] = P.k3.x; kx[13] = P.k3.y; kx[14] = P.k3.z; kx[15] = P.k3.w;
        vx[0] = P.v0.x; vx[1] = P.v0.y; vx[2] = P.v0.z; vx[3] = P.v0.w; vx[4] = P.v1.x; vx[5] = P.v1.y; vx[6] = P.v1.z; vx[7] = P.v1.w;
        vx[8] = P.v2.x; vx[9] = P.v2.y; vx[10] = P.v2.z; vx[11] = P.v2.w; vx[12] = P.v3.x; vx[13] = P.v3.y; vx[14] = P.v3.z; vx[15] = P.v3.w;
        if (act && (W + rel >= DEC_T) && (g != 0 || tl == 0)) {
            const size_t offk = ((((size_t)bs * 2 + 0) * W + (W + rel - DEC_T)) * 8 + j) * HD + 16 * part, offv = offk + (size_t)W * 8 * HD;
            float* okv = a.out + ((g == 0) ? O_KV128S : (g == 1) ? O_KV512S : O_KV2048S);
            GAS f32x4* ko = (GAS f32x4*)(okv + offk); GAS f32x4* vo = (GAS f32x4*)(okv + offv);
            ko[0] = P.k0; ko[1] = P.k1; ko[2] = P.k2; ko[3] = P.k3; vo[0] = P.v0; vo[1] = P.v1; vo[2] = P.v2; vo[3] = P.v3;
        }
    }
    float s = 0.f;
#pragma unroll
    for (int k = 0; k < 16; ++k) s += q[k] * kx[k];
    s += __shfl_xor(s, 1); s += __shfl_xor(s, 2);
    s *= 0.125f;
    if (act) {
        const float mn = fmaxf(mrun, s), sc = __expf(mrun - mn), p = __expf(s - mn);
        sum = sum * sc + p; mrun = mn;
#pragma unroll
        for (int k = 0; k < 16; ++k) o[k] = o[k] * sc + p * vx[k];
    }
}
__device__ __forceinline__ void p3_sample_attn(const Frame& F, const Args& a) {
    unsigned char* ws = a.ws;
    const bf16* Q = (const bf16*)(ws + WS_Q); const bf16* K = (const bf16*)(ws + WS_K); const bf16* V = (const bf16*)(ws + WS_V);
    bf16* Bb = (bf16*)(ws + WS_B);
    const int lane = F.lane, ksub = lane >> 2, part = lane & 3, half = F.wave & 1;
    const int it = F.vcu * 4 + (F.wave >> 1);
    LAS float* xch = (LAS float*)(F.lds + RING_OFF) + (F.wave >> 1) * 80;
    float mrun = -1e30f, sum = 0.f; float o[16];
#pragma unroll
    for (int k = 0; k < 16; ++k) o[k] = 0.f;
    const bool live = it < M_SAMPLE * 8;
    const int m = M_PROMPT + (live ? (it >> 3) : 0), j = it & 7, bs = (m - M_PROMPT) >> 2, tl = (m - M_PROMPT) & 3;
    if (live) {
        SaPass PA = sa_load(half, a, Q, K, V, m, j, bs, tl, ksub, part);
#pragma unroll 1
        for (int idx = half; idx < 27; idx += 2) {
            const int nx = (idx + 2 < 27) ? idx + 2 : idx;
            const SaPass PB = sa_load(nx, a, Q, K, V, m, j, bs, tl, ksub, part);
            sa_proc(PA, idx, a, j, bs, tl, ksub, part, mrun, sum, o);
            PA = PB;
        }
    }
    const float M = wave_max(mrun), fl = __expf(mrun - M);
    sum *= fl;
#pragma unroll
    for (int k = 0; k < 16; ++k) o[k] *= fl;
#pragma unroll
    for (int off = 4; off < 64; off <<= 1) {
        sum += __shfl_xor(sum, off);
#pragma unroll
        for (int k = 0; k < 16; ++k) o[k] += __shfl_xor(o[k], off);
    }
    if (half == 1 && ksub == 0) { xch[part * 18] = M; xch[part * 18 + 1] = sum;
#pragma unroll
        for (int k = 0; k < 16; ++k) xch[part * 18 + 2 + k] = o[k]; }
    __syncthreads();
    if (half == 0 && ksub == 0 && live) {
        const float M1 = xch[part * 18], s1 = xch[part * 18 + 1];
        const float Mn = fmaxf(M, M1), f0 = __expf(M - Mn), f1 = __expf(M1 - Mn);
        const float rl = 1.0f / (sum * f0 + s1 * f1);
        float r[16];
#pragma unroll
        for (int k = 0; k < 16; ++k) r[k] = (o[k] * f0 + xch[part * 18 + 2 + k] * f1) * rl;
        v4u o0, o1; o0.x = pk2(r[0], r[1]); o0.y = pk2(r[2], r[3]); o0.z = pk2(r[4], r[5]); o0.w = pk2(r[6], r[7]);
        o1.x = pk2(r[8], r[9]); o1.y = pk2(r[10], r[11]); o1.z = pk2(r[12], r[13]); o1.w = pk2(r[14], r[15]);
        GAS v4u* op = (GAS v4u*)(Bb + (size_t)m * D_A + j * HD + 16 * part); op[0] = o0; op[1] = o1;
    }
    __syncthreads();
}

__device__ __forceinline__ void p3_combine(const Frame& F, const Args& a) {
    unsigned char* ws = a.ws;
    const bf16* OG = (const bf16*)(ws + WS_OG); const float* LSE = (const float*)(ws + WS_LSE); bf16* Bb = (bf16*)(ws + WS_B);
    const size_t gt = (size_t)blockIdx.x * 512 + F.tid, NT = (size_t)F.G * 512, total = (size_t)M_PROMPT * 64;
    for (size_t i0 = gt; i0 < total; i0 += 8 * NT) {
        v4u a0[8], a1[8], a2[8]; float l0[8], l1[8], l2[8];
#pragma unroll
        for (int k = 0; k < 8; ++k) { const size_t i = i0 + k * NT; if (i < total) { const size_t m = i >> 6; const int c8 = (int)(i & 63), j = c8 >> 3;
            l0[k] = LSE[((size_t)0 * M_PROMPT + m) * 8 + j]; l1[k] = LSE[((size_t)1 * M_PROMPT + m) * 8 + j]; l2[k] = LSE[((size_t)2 * M_PROMPT + m) * 8 + j];
            a0[k] = ((const GAS v4u*)(OG + ((size_t)0 * M_PROMPT + m) * 512))[c8]; a1[k] = ((const GAS v4u*)(OG + ((size_t)1 * M_PROMPT + m) * 512))[c8]; a2[k] = ((const GAS v4u*)(OG + ((size_t)2 * M_PROMPT + m) * 512))[c8]; } }
#pragma unroll
        for (int k = 0; k < 8; ++k) { const size_t i = i0 + k * NT; if (i < total) { const size_t m = i >> 6; const int c8 = (int)(i & 63);
            const float mx = fmaxf(l0[k], fmaxf(l1[k], l2[k]));
            float w0 = __builtin_amdgcn_exp2f(l0[k] - mx), w1 = __builtin_amdgcn_exp2f(l1[k] - mx), w2 = __builtin_amdgcn_exp2f(l2[k] - mx);
            const float rs = 1.0f / (w0 + w1 + w2); w0 *= rs; w1 *= rs; w2 *= rs;
            const v4u x0 = a0[k], x1 = a1[k], x2 = a2[k];
            v4u o;
            o.x = pk2(w0 * bflo(x0.x) + w1 * bflo(x1.x) + w2 * bflo(x2.x), w0 * bfhi(x0.x) + w1 * bfhi(x1.x) + w2 * bfhi(x2.x));
            o.y = pk2(w0 * bflo(x0.y) + w1 * bflo(x1.y) + w2 * bflo(x2.y), w0 * bfhi(x0.y) + w1 * bfhi(x1.y) + w2 * bfhi(x2.y));
            o.z = pk2(w0 * bflo(x0.z) + w1 * bflo(x1.z) + w2 * bflo(x2.z), w0 * bfhi(x0.z) + w1 * bfhi(x1.z) + w2 * bfhi(x2.z));
            o.w = pk2(w0 * bflo(x0.w) + w1 * bflo(x1.w) + w2 * bflo(x2.w), w0 * bfhi(x0.w) + w1 * bfhi(x1.w) + w2 * bfhi(x2.w));
            ((GAS v4u*)(Bb + m * 512))[c8] = o; } }
    }
}

constexpr int MX_V = 0;
__device__ __forceinline__ float ssv_rstd(const float* SSV, int m) {
    const f32x4 s0 = ((const GAS f32x4*)(SSV + (size_t)m * 8))[0], s1 = ((const GAS f32x4*)(SSV + (size_t)m * 8))[1];
    const float ss = ((s0.x + s0.y) + (s0.z + s0.w)) + ((s1.x + s1.y) + (s1.z + s1.w));
    return __builtin_amdgcn_rsqf(ss * (1.f / D_A) + EPS);
}
constexpr int MX_C = 32768, MX_CLD = 132;
__device__ __forceinline__ void p3_mix(const Frame& F, const Args& a) {
    unsigned char* ws = a.ws;
    const bf16* U = (const bf16*)(ws + WS_U); const bf16* VA = (const bf16*)(ws + WS_VA); const bf16* WSB = (const bf16*)(ws + WS_WSB); const float* SSV = (const float*)(ws + WS_SSV);
    bf16* Ab = (bf16*)(ws + WS_A);
    const float* g_v = a.in[9]; const float* b_s = a.in[11];
    const int tid = F.tid, lane = F.lane, w = F.wave, l31 = lane & 31, hi = lane >> 5;
    const LAS unsigned char* ldsV = F.lds + MX_V;
    LAS float* ldsC = (LAS float*)(F.lds + MX_C);
    const int tb = w >> 1, cb = w & 1;
    auto LOAD = [&](int it, v4u (&x)[4], v4u (&u)[4], float (&rs)[4], float (&bi)[4]) {
        const int g = it & 3, chunk0 = (it >> 2) * 128;
#pragma unroll
        for (int k = 0; k < 4; ++k) { const int cidx = tid + 512 * k, s = cidx >> 4, c = cidx & 15; const size_t off = (size_t)(chunk0 + s) * D_A + g * 128 + c * 8;
            x[k] = *(const GAS v4u*)(VA + off); u[k] = *(const GAS v4u*)(U + off); rs[k] = ssv_rstd(SSV, chunk0 + s); bi[k] = b_s[g * 128 + s]; }
    };
    auto PROC = [&](int it, const v4u (&xx)[4], const v4u (&uu)[4], const float (&rsv)[4], const float (&bi)[4]) {
        const int g = it & 3, ck = it >> 2, chunk0 = ck * 128;
        const bool lastc = (ck & 31) == 31; const int bb = ck >> 5;
        const bf16* wrow = WSB + ((size_t)g * 128 + 32 * tb + l31) * 128 + 4 * hi;
        v2u wa[8][2];
#pragma unroll
        for (int ks = 0; ks < 8; ++ks) if (ks <= 2 * tb + 1) { wa[ks][0] = *(const GAS v2u*)(wrow + 16 * ks); wa[ks][1] = *(const GAS v2u*)(wrow + 16 * ks + 8); }
#pragma unroll
        for (int k = 0; k < 4; ++k) {
            const int cidx = tid + 512 * k, s = cidx >> 4, c = cidx & 15;
            const float rs = rsv[k]; const v4u x = xx[k];
            const f32x4 g0 = *(const GAS f32x4*)(g_v + g * 128 + c * 8), g1 = *(const GAS f32x4*)(g_v + g * 128 + c * 8 + 4);
            const float v0 = bflo(x.x) * rs * g0.x, v1 = bfhi(x.x) * rs * g0.y, v2 = bflo(x.y) * rs * g0.z, v3 = bfhi(x.y) * rs * g0.w;
            const float v4 = bflo(x.z) * rs * g1.x, v5 = bfhi(x.z) * rs * g1.y, v6 = bflo(x.w) * rs * g1.z, v7 = bfhi(x.w) * rs * g1.w;
            v4u o; o.x = pk2(v0, v1); o.y = pk2(v2, v3); o.z = pk2(v4, v5); o.w = pk2(v6, v7);
            *(LAS v4u*)(F.lds + MX_V + ((s >> 3) * 4 + (c >> 2)) * 512 + (s & 7) * 64 + (c & 3) * 16) = o;
            if (lastc) { float* cv = a.out + O_CVP + ((size_t)bb * 128 + s) * D_A + g * 128 + c * 8; *(GAS f32x4*)cv = (f32x4){v0, v1, v2, v3}; *(GAS f32x4*)(cv + 4) = (f32x4){v4, v5, v6, v7}; }
        }
        __syncthreads();
        f32x16 C[2];
        C[0] = (f32x16){0.f,0.f,0.f,0.f,0.f,0.f,0.f,0.f,0.f,0.f,0.f,0.f,0.f,0.f,0.f,0.f}; C[1] = C[0];
        const int vbase = (4 * hi + ((lane & 15) >> 2)) * 64 + ((lane >> 4) & 1) * 32 + (lane & 3) * 8;
#pragma unroll
        for (int ks = 0; ks < 8; ++ks) {
            if (ks <= 2 * tb + 1) {
                const bf16x8_t af = __builtin_bit_cast(bf16x8_t, (v4u){wa[ks][0].x, wa[ks][0].y, wa[ks][1].x, wa[ks][1].y});
#pragma unroll
                for (int nb = 0; nb < 2; ++nb) {
                    const int st = (2 * ks) * 4 + (2 * cb + nb);
                    const s16x4_t lo = vtr(ldsV + st * 512 + vbase), hv = vtr(ldsV + (st + 4) * 512 + vbase);
                    const bf16x8_t vb = (bf16x8_t){lo[0], lo[1], lo[2], lo[3], hv[0], hv[1], hv[2], hv[3]};
                    C[nb] = __builtin_amdgcn_mfma_f32_32x32x16_bf16(af, vb, C[nb], 0, 0, 0);
                }
            }
        }
#pragma unroll
        for (int rr = 0; rr < 16; ++rr) { const int t = 32 * tb + crow(rr, hi);
#pragma unroll
            for (int nb = 0; nb < 2; ++nb) ldsC[t * MX_CLD + 64 * cb + 32 * nb + l31] = C[nb][rr]; }
        __syncthreads();
#pragma unroll
        for (int k = 0; k < 4; ++k) {
            const int cidx = tid + 512 * k, s = cidx >> 4, c = cidx & 15;
            const f32x4 m0 = *(const LAS f32x4*)(ldsC + s * MX_CLD + c * 8), m1 = *(const LAS f32x4*)(ldsC + s * MX_CLD + c * 8 + 4);
            const v4u u = uu[k]; const float b = bi[k];
            v4u o; o.x = pk2(bflo(u.x) * (m0.x + b), bfhi(u.x) * (m0.y + b)); o.y = pk2(bflo(u.y) * (m0.z + b), bfhi(u.y) * (m0.w + b));
            o.z = pk2(bflo(u.z) * (m1.x + b), bfhi(u.z) * (m1.y + b)); o.w = pk2(bflo(u.w) * (m1.z + b), bfhi(u.w) * (m1.w + b));
            *(GAS v4u*)(Ab + (size_t)(chunk0 + s) * D_A + g * 128 + c * 8) = o;
        }
    };
    v4u xa[4], ua[4], xb[4], ub[4]; float ra[4], ba[4], rb[4], bb2[4];
    int it = F.vcu;
    if (it < 512) {
        LOAD(it, xa, ua, ra, ba);
        for (;;) {
            int n = it + F.G; bool hn = n < 512;
            if (hn) LOAD(n, xb, ub, rb, bb2);
            PROC(it, xa, ua, ra, ba);
            if (!hn) break;
            it = n; n = it + F.G; hn = n < 512;
            if (hn) LOAD(n, xa, ua, ra, ba);
            PROC(it, xb, ub, rb, bb2);
            if (!hn) break;
            it = n;
        }
    }
    __syncthreads();
}
__device__ __forceinline__ void p3_mix_sample(const Frame& F, const Args& a) {
    unsigned char* ws = a.ws;
    const int gw = F.vcu * NWAVES + F.wave, NGW = F.G * NWAVES, lane = F.lane;
    const bf16* U = (const bf16*)(ws + WS_U); const bf16* VA = (const bf16*)(ws + WS_VA); const float* SSV = (const float*)(ws + WS_SSV);
    bf16* Ab = (bf16*)(ws + WS_A);
    const float* w_s = a.in[10]; const float* b_s = a.in[11]; const float* g_v = a.in[9];
    for (int it = gw; it < M_SAMPLE * 4; it += NGW) {
        const int m = M_PROMPT + (it >> 2), g = it & 3;
        const int chunk0 = M_PROMPT + ((m - M_PROMPT) & ~3), tl = (m - M_PROMPT) & 3;
        const float gv0 = g_v[g * 128 + 2 * lane], gv1 = g_v[g * 128 + 2 * lane + 1];
        float acc0 = 0.f, acc1 = 0.f;
        const float* wrow = w_s + ((size_t)g * 128 + tl) * 128;
        float wv[4], rs[4]; unsigned vv[4];
#pragma unroll
        for (int s = 0; s < 4; ++s) { const int sc = s <= tl ? s : tl; wv[s] = wrow[sc]; rs[s] = ssv_rstd(SSV, chunk0 + sc); vv[s] = ((const GAS unsigned*)(VA + (size_t)(chunk0 + sc) * D_A + g * 128))[lane]; }
        const float bias = b_s[g * 128 + tl];
        const unsigned uu = ((const GAS unsigned*)(U + (size_t)m * D_A + g * 128))[lane];
#pragma unroll
        for (int s = 0; s < 4; ++s) if (s <= tl) {
            const float n0 = bflo(vv[s]) * rs[s] * gv0, n1 = bfhi(vv[s]) * rs[s] * gv1;
            acc0 += wv[s] * bf2f((unsigned short)f2bf(n0)); acc1 += wv[s] * bf2f((unsigned short)f2bf(n1));
            if (s == tl) { float* cv = a.out + O_CVS + (size_t)(m - M_PROMPT) * D_A + g * 128 + 2 * lane; cv[0] = n0; cv[1] = n1; }
        }
        ((GAS unsigned*)(Ab + (size_t)m * D_A + g * 128))[lane] = pk2(bflo(uu) * (acc0 + bias), bfhi(uu) * (acc1 + bias));
    }
}

#define SG_ROWS() const int lane = F.lane, w = F.wave, tok = lane & 15, fq = lane >> 4, sidx = 16 * w + tok, m = M_PROMPT + sidx; (void)tok
#define SG_TILE(rg, cg) const int lane = F.lane, w = F.wave, tok = lane & 15, fq = lane >> 4, sidx = 32 * (rg) + 16 * (w >> 2) + tok, m = M_PROMPT + sidx, c0 = 64 * (cg) + 16 * (w & 3), r0s = 32 * (rg), cg0 = 64 * (cg); LAS float* red = (LAS float*)(F.lds + RING_OFF); (void)tok; (void)m
__device__ __forceinline__ void s1_job(const Frame& F, const Args& a, int cb) {
    unsigned char* ws = a.ws; SG_ROWS();
    sg::f32x4 acc[4]; float ssu = 0.f;
#pragma unroll
    for (int nt = 0; nt < 4; ++nt) acc[nt] = (sg::f32x4){0.f, 0.f, 0.f, 0.f};
    sg::core<4, false>(acc, ssu, ws + WS_H, D, m, (const unsigned short*)(ws + WS_WIN), D, 64 * cb, 0, D, lane);
    const int b = sidx >> 2, tl = sidx & 3;
    if (cb < 8) {
#pragma unroll
        for (int nt = 0; nt < 4; ++nt) { v2u o; o.x = sg::cvt2(sg::gelu(acc[nt][0]), sg::gelu(acc[nt][1])); o.y = sg::cvt2(sg::gelu(acc[nt][2]), sg::gelu(acc[nt][3]));
            *(GAS v2u*)((bf16*)(ws + WS_U) + (size_t)m * D_A + 64 * cb + 16 * nt + 4 * fq) = o; }
    } else if (cb < 16) {
        float ss = 0.f;
#pragma unroll
        for (int nt = 0; nt < 4; ++nt) { const float g0 = sg::gelu(acc[nt][0]), g1 = sg::gelu(acc[nt][1]), g2 = sg::gelu(acc[nt][2]), g3 = sg::gelu(acc[nt][3]);
            ss += (g0 * g0 + g1 * g1) + (g2 * g2 + g3 * g3); v2u o; o.x = sg::cvt2(g0, g1); o.y = sg::cvt2(g2, g3);
            *(GAS v2u*)((bf16*)(ws + WS_VA) + (size_t)m * D_A + 64 * (cb - 8) + 16 * nt + 4 * fq) = o; }
        ss += __shfl_xor(ss, 16); ss += __shfl_xor(ss, 32);
        if (fq == 0) ((float*)(ws + WS_SSV))[(size_t)m * 8 + (cb - 8)] = ss;
    } else if (cb < 88) {
        const bool isv = cb >= 64, isk = !isv && cb >= 40; const int hd = cb - (isv ? 64 : isk ? 40 : 16), g = hd >> 3, hh = hd & 7;
        float y[4][4];
#pragma unroll
        for (int nt = 0; nt < 4; ++nt)
#pragma unroll
            for (int r = 0; r < 4; ++r) y[nt][r] = acc[nt][r];
        if (!isv) {
            float ss = 0.f;
#pragma unroll
            for (int nt = 0; nt < 4; ++nt) ss += (y[nt][0] * y[nt][0] + y[nt][1] * y[nt][1]) + (y[nt][2] * y[nt][2] + y[nt][3] * y[nt][3]);
            ss += __shfl_xor(ss, 16); ss += __shfl_xor(ss, 32);
            const float rn = __builtin_amdgcn_rsqf(ss * (1.f / HD) + EPS);
            const float* gp = isk ? a.in[13] : a.in[12];
#pragma unroll
            for (int nt = 0; nt < 4; ++nt) { const f32x4 gg = *(const GAS f32x4*)(gp + 16 * nt + 4 * fq); y[nt][0] *= rn * gg.x; y[nt][1] *= rn * gg.y; y[nt][2] *= rn * gg.z; y[nt][3] *= rn * gg.w; }
            const float* rt = (const float*)(ws + WS_ROT) + (size_t)(4096 + tl) * 16 + 8 * (fq & 1);
            const f32x4 t0 = *(const GAS f32x4*)rt, t1 = *(const GAS f32x4*)(rt + 4);
            const float cs[4] = {t0.x, t0.z, t1.x, t1.z}, sn[4] = {t0.y, t0.w, t1.y, t1.w};
#pragma unroll
            for (int r = 0; r < 4; ++r) { const float pr = __shfl_xor(y[0][r], 32); y[0][r] = (fq < 2) ? (y[0][r] * cs[r] - pr * sn[r]) : (y[0][r] * cs[r] + pr * sn[r]); }
        }
        bf16* dst = (bf16*)(ws + (isv ? WS_V : isk ? WS_K : WS_Q)) + (size_t)m * DQKV + hd * HD;
#pragma unroll
        for (int nt = 0; nt < 4; ++nt) { v2u o; o.x = sg::cvt2(y[nt][0], y[nt][1]); o.y = sg::cvt2(y[nt][2], y[nt][3]); *(GAS v2u*)(dst + 16 * nt + 4 * fq) = o; }
        if (isk || isv) {
            const int W = 128 << (2 * g); const size_t oks = (g == 0) ? O_KV128S : (g == 1) ? O_KV512S : O_KV2048S;
            float* o = a.out + oks + ((((size_t)b * 2 + (isv ? 1 : 0)) * W + (W - DEC_T + tl)) * 8 + hh) * HD + 4 * fq;
#pragma unroll
            for (int nt = 0; nt < 4; ++nt) *(GAS f32x4*)(o + 16 * nt) = (f32x4){y[nt][0], y[nt][1], y[nt][2], y[nt][3]};
        }
    } else {
        bf16* dst = (bf16*)(ws + (cb < 104 ? WS_GA : WS_GB)) + (size_t)m * D + 64 * (cb - (cb < 104 ? 88 : 104));
#pragma unroll
        for (int nt = 0; nt < 4; ++nt) { v2u o; o.x = sg::cvt2(sg::sigm(acc[nt][0]), sg::sigm(acc[nt][1])); o.y = sg::cvt2(sg::sigm(acc[nt][2]), sg::sigm(acc[nt][3]));
            *(GAS v2u*)(dst + 16 * nt + 4 * fq) = o; }
    }
}
__device__ __forceinline__ void s3_job(const Frame& F, const Args& a, int j) {
    unsigned char* ws = a.ws; const int which = j & 1, rg = (j >> 1) & 3, cg = j >> 3; SG_TILE(rg, cg);
    sg::f32x4 acc[1]; float ssu = 0.f;
    sg::core8<false, 2>(acc[0], ssu, red, ws + (which ? WS_B : WS_A), D_A, M_PROMPT + r0s, (const unsigned short*)(ws + (which ? WS_WOB : WS_WOA)), D_A, cg0, 0, lane, w);
    const v2u gt = *(const GAS v2u*)((const bf16*)(ws + (which ? WS_GB : WS_GA)) + (size_t)m * D + c0 + 4 * fq);
    float* o = (float*)(ws + WS_MGS) + (size_t)sidx * D + c0 + 4 * fq;
    atomicAdd(o + 0, bflo(gt.x) * acc[0][0]); atomicAdd(o + 1, bfhi(gt.x) * acc[0][1]); atomicAdd(o + 2, bflo(gt.y) * acc[0][2]); atomicAdd(o + 3, bfhi(gt.y) * acc[0][3]);
}
__device__ __forceinline__ void s4_job(const Frame& F, const Args& a, int j) {
    unsigned char* ws = a.ws; const int kq = j & 3, rg = (j >> 2) & 3, cg = j >> 4; SG_TILE(rg, cg);
    sg::f32x4 acc[1]; float ssu = 0.f;
    sg::core8<true, 1>(acc[0], ssu, red, ws + WS_MGS, D, r0s, (const unsigned short*)(ws + WS_WO), D, cg0, 256 * kq, lane, w);
    float* o = (float*)(ws + WS_X1S) + (size_t)sidx * D + c0 + 4 * fq;
    atomicAdd(o + 0, acc[0][0]); atomicAdd(o + 1, acc[0][1]); atomicAdd(o + 2, acc[0][2]); atomicAdd(o + 3, acc[0][3]);
}
__device__ __forceinline__ void s5_job(const Frame& F, const Args& a, int j) {
    unsigned char* ws = a.ws; const int rg = j & 3, cg = j >> 2; SG_TILE(rg, cg);
    sg::f32x4 acc[1]; float ss = 0.f;
    sg::core8<true, 4>(acc[0], ss, red, ws + WS_X1S, D, r0s, (const unsigned short*)(ws + WS_WFF1), D, cg0, 0, lane, w);
    const float r = __builtin_amdgcn_rsqf(ss * (1.f / D) + EPS);
    float fv[4];
#pragma unroll
    for (int e = 0; e < 4; ++e) { const float t = fmaxf(acc[0][e] * r, 0.f); fv[e] = t * t; }
    v2u o; o.x = sg::cvt2(fv[0], fv[1]); o.y = sg::cvt2(fv[2], fv[3]);
    *(GAS v2u*)((bf16*)(ws + WS_F) + (size_t)m * D_FF + c0 + 4 * fq) = o;
    { const int row = F.tid >> 2, col = 4 * j + (F.tid & 3); ((float*)(ws + WS_X2S))[(size_t)row * D + col] = ((const float*)(ws + WS_X1S))[(size_t)row * D + col]; }
}
__device__ __forceinline__ void s6_job(const Frame& F, const Args& a, int j) {
    unsigned char* ws = a.ws; const int kq = j & 3, rg = (j >> 2) & 3, cg = j >> 4; SG_TILE(rg, cg);
    sg::f32x4 acc[1]; float ssu = 0.f;
    sg::core8<false, 4>(acc[0], ssu, red, ws + WS_F, D_FF, M_PROMPT + r0s, (const unsigned short*)(ws + WS_WFF2), D_FF, cg0, 1024 * kq, lane, w);
    float* o = (float*)(ws + WS_X2S) + (size_t)sidx * D + c0 + 4 * fq;
    atomicAdd(o + 0, acc[0][0]); atomicAdd(o + 1, acc[0][1]); atomicAdd(o + 2, acc[0][2]); atomicAdd(o + 3, acc[0][3]);
}
__device__ __forceinline__ void s7_job(const Frame& F, const Args& a, int j) {
    unsigned char* ws = a.ws; const int rg = j & 3, cg = j >> 2; SG_TILE(rg, cg);
    sg::f32x4 acc1[1], acc2[1]; float ss = 0.f, ssu = 0.f;
    sg::core8<true, 4>(acc1[0], ss, red, ws + WS_X2S, D, r0s, (const unsigned short*)(ws + WS_WPG), D, cg0, 0, lane, w);
    sg::core8<false, 1>(acc2[0], ssu, red, ws + WS_PE, D_PLE, M_PROMPT + r0s, (const unsigned short*)(ws + WS_WPP), D_PLE, cg0, 0, lane, w);
    const float r = __builtin_amdgcn_rsqf(ss * (1.f / D) + EPS);
    const size_t off = (size_t)sidx * D + c0 + 4 * fq;
    const f32x4 x2 = *(const GAS f32x4*)((const float*)(ws + WS_X2S) + off);
    f32x4 y; y.x = x2.x + sg::sigm(acc1[0][0] * r) * acc2[0][0]; y.y = x2.y + sg::sigm(acc1[0][1] * r) * acc2[0][1]; y.z = x2.z + sg::sigm(acc1[0][2] * r) * acc2[0][2]; y.w = x2.w + sg::sigm(acc1[0][3] * r) * acc2[0][3];
    *(GAS f32x4*)(a.out + O_YS + off) = y;
}

__global__ void __launch_bounds__(NWAVES * 64, 2) mega_fwd(Args args) {
    extern __shared__ __attribute__((aligned(16))) unsigned char lds[];
    Frame F;
    F.lds = (LAS unsigned char*)lds;
    F.tid = threadIdx.x; F.lane = F.tid & 63; F.wave = __builtin_amdgcn_readfirstlane(F.tid >> 6);
    F.G = gridDim.x; { const int bx = blockIdx.x; F.vcu = (F.G % 8 == 0) ? (bx % 8) * (F.G / 8) + bx / 8 : bx; }
#define REFRAME() do { int t_ = threadIdx.x; asm volatile("" : "+v"(t_)); F.tid = t_; F.lane = t_ & 63; F.wave = __builtin_amdgcn_readfirstlane(t_ >> 6); } while (0)
    unsigned char* ws = args.ws;
    for (int u = F.tid; u < (LDS_BYTES - LDSCTL_OFF) / 4; u += NWAVES * 64) ((LAS unsigned*)(F.lds + LDSCTL_OFF))[u] = 0u;
    __syncthreads();
    volatile LAS unsigned* MISC = (volatile LAS unsigned*)(F.lds + MISC_OFF);
    XcdBarrier bar = xcd_barrier_post((unsigned*)(ws + WS_CTL) + CW_BAR, MISC + 8);
    int bar_i = 0;
#define GRID_BAR(BN) do { xcd_barrier<BN>(bar, args.in[6], args.out, (long)bar_i * (256 * 448) + (long)blockIdx.x * (448 * (BN))); bar_i += (BN); } while (0)
    const int G = F.G, bx = (int)blockIdx.x;

    REFRAME();
    p0_prologue(F, args);
    GRID_BAR(8);
    { pg8::Gemm g{(const pg8::bf16_t*)(ws + WS_PE), (const pg8::bf16_t*)(ws + WS_WPP), M_PROMPT, D, D_PLE}; pg8::HalfOrder S{bx - 128};
      pg8::EpiGate<2> E{(bf16*)(ws + WS_PJB), nullptr, nullptr, D};
      pg8::gemm_phase<pg8::EpiGate<2>, pg8::HalfOrder, true, true, pg8::KvCopy>(F.lds + RING_OFF, g, S, E, pg8::KvCopy{{args.in[6], args.out, pg8::KVC_TOTAL, {}}, 1920}); }
    { pg8::Gemm g{(const pg8::bf16_t*)(ws + WS_H), (const pg8::bf16_t*)(ws + WS_WIN), M_PROMPT, D_IN, D}; pg8::StaticOrder S; S.init(M_PROMPT, D_IN, G, bx);
      pg8::EpiIn E{ws, args.out, args.in[12], args.in[13], (PG8_LAS float*)(F.lds + ROTT_OFF)};
      pg8::gemm_phase<pg8::EpiIn, pg8::StaticOrder, true, true, pg8::KvCopy>(F.lds + RING_OFF, g, S, E, pg8::KvCopy{{args.in[6], args.out, pg8::KVC_TOTAL, {}}, 0}); }
    REFRAME(); if (bx >= 128 && bx < 128 + 120) s1_job(F, args, bx - 128);
    GRID_BAR(28);
    REFRAME(); p3_swa(F, args);
    REFRAME(); p3_sample_attn(F, args);
    REFRAME(); p3_mix(F, args);
    REFRAME(); p3_mix_sample(F, args);
    GRID_BAR(28);
    { pg8::Gemm g{(const pg8::bf16_t*)(ws + WS_A), (const pg8::bf16_t*)(ws + WS_WOA), M_PROMPT, D, D_A}; pg8::StaticOrder S; S.init(M_PROMPT, D, G, bx);
      pg8::EpiGate<0> E{(bf16*)(ws + WS_T1B), (const bf16*)(ws + WS_GA), nullptr, D};
      pg8::gemm_phase<pg8::EpiGate<0>, pg8::StaticOrder, true, true, pg8::KvCopy>(F.lds + RING_OFF, g, S, E, pg8::KvCopy{{args.in[6], args.out, pg8::KVC_TOTAL, {}}, 2176}); }
    REFRAME(); p3_combine(F, args);
    REFRAME(); if (bx < 128) s3_job(F, args, bx);
    GRID_BAR(8);
    { pg8::Gemm g{(const pg8::bf16_t*)(ws + WS_B), (const pg8::bf16_t*)(ws + WS_WOB), M_PROMPT, D, D_A}; pg8::StaticOrder S; S.init(M_PROMPT, D, G, bx);
      pg8::EpiGate<1> E{(bf16*)(ws + WS_MG), (const bf16*)(ws + WS_GB), (const bf16*)(ws + WS_T1B), D};
      pg8::gemm_phase<pg8::EpiGate<1>, pg8::StaticOrder, true, true, pg8::KvCopy>(F.lds + RING_OFF, g, S, E, pg8::KvCopy{{args.in[6], args.out, pg8::KVC_TOTAL, {}}, 2432}); }
    REFRAME(); s4_job(F, args, bx);
    GRID_BAR(10);
    { pg8::Gemm g{(const pg8::bf16_t*)(ws + WS_MG), (const pg8::bf16_t*)(ws + WS_WO), M_PROMPT, D, D}; pg8::StaticOrder S; S.init(M_PROMPT, D, G, bx);
      pg8::EpiResid<false> E{args.in[0], (bf16*)(ws + WS_XB1), (float*)(ws + WS_SSQ1), nullptr};
      pg8::gemm_phase<pg8::EpiResid<false>, pg8::StaticOrder, true, true, pg8::KvCopy>(F.lds + RING_OFF, g, S, E, pg8::KvCopy{{args.in[6], args.out, pg8::KVC_TOTAL, {}}, 2688}); }
    REFRAME(); s5_job(F, args, bx);
    GRID_BAR(10);
    { pg8::Gemm g{(const pg8::bf16_t*)(ws + WS_XB1), (const pg8::bf16_t*)(ws + WS_WFF1), M_PROMPT, D_FF, D}; pg8::StaticOrder S; S.init(M_PROMPT, D_FF, G, bx);
      pg8::EpiFF1 E{(bf16*)(ws + WS_F), D_FF};
      pg8::gemm_phase<pg8::EpiFF1, pg8::StaticOrder, true, true, pg8::KvCopy>(F.lds + RING_OFF, g, S, E, pg8::KvCopy{{args.in[6], args.out, pg8::KVC_TOTAL, {}}, 2944}); }
    REFRAME(); s6_job(F, args, bx);
    GRID_BAR(10);
    { pg8::Gemm g{(const pg8::bf16_t*)(ws + WS_F), (const pg8::bf16_t*)(ws + WS_WFF2), M_PROMPT, D, D_FF}; pg8::StaticOrder S; S.init(M_PROMPT, D, G, bx);
      pg8::EpiResid<true> E{ws + WS_XB1, (bf16*)(ws + WS_XB2), (float*)(ws + WS_SSQ2), (const float*)(ws + WS_SSQ1)};
      pg8::gemm_phase<pg8::EpiResid<true>, pg8::StaticOrder, true, true, pg8::KvCopy>(F.lds + RING_OFF, g, S, E, pg8::KvCopy{{args.in[6], args.out, pg8::KVC_TOTAL, {}}, 3968}); }
    REFRAME(); if (bx < 64) s7_job(F, args, bx);
    GRID_BAR(10);
    { pg8::Gemm g{(const pg8::bf16_t*)(ws + WS_XB2), (const pg8::bf16_t*)(ws + WS_WPG), M_PROMPT, D, D}; pg8::StaticOrder S; S.init(M_PROMPT, D, G, bx);
      pg8::EpiFinal E{args.out, (const bf16*)(ws + WS_XB2), (const bf16*)(ws + WS_PJB), (const float*)(ws + WS_SSQ2)};
      pg8::gemm_phase<pg8::EpiFinal, pg8::StaticOrder, true, true, pg8::KvCopy>(F.lds + RING_OFF, g, S, E, pg8::KvCopy{{args.in[6], args.out, pg8::KVC_TOTAL, {}}, 4224}); }
}

extern "C" void kernel_launch(void* const* d_in, const int* in_sizes, int n_in, void* d_out, int out_size, void* d_ws, size_t ws_size, hipStream_t stream) {
    static int grid = 0;
    if (grid == 0) {
        if (n_in != 23 || out_size != (int)O_END || ws_size < WS_END2) { fprintf(stderr, "kernel_launch: unexpected shapes: n_in %d out %d ws %zu (need %zu)\n", n_in, out_size, ws_size, (size_t)WS_END2); grid = -1; return; }
        int dev = 0, cus = 0, per_cu = 0;
        if (hipGetDevice(&dev) != hipSuccess || hipDeviceGetAttribute(&cus, hipDeviceAttributeMultiprocessorCount, dev) != hipSuccess) { grid = -1; return; }
        if (hipFuncSetAttribute((const void*)mega_fwd, hipFuncAttributeMaxDynamicSharedMemorySize, LDS_BYTES) != hipSuccess) { fprintf(stderr, "kernel_launch: hipFuncSetAttribute failed\n"); grid = -1; return; }
        if (hipOccupancyMaxActiveBlocksPerMultiprocessor(&per_cu, (const void*)mega_fwd, NWAVES * 64, LDS_BYTES) != hipSuccess || per_cu < 1) { fprintf(stderr, "kernel_launch: occupancy query says %d blocks/CU\n", per_cu); }
        (void)hipGetLastError();
        grid = cus;
        if (grid != 256) { fprintf(stderr, "kernel_launch: this kernel's static work split needs 256 CUs, device has %d\n", cus); grid = -1; return; }
    }
    if (grid < 0) return;
    if (hipMemsetAsync((char*)d_ws + WS_CTL, 0, CTL_ZERO_BYTES, stream) != hipSuccess) { fprintf(stderr, "kernel_launch: memset failed\n"); return; }
    Args a{};
    for (int i = 0; i < 23; ++i) a.in[i] = (const float*)d_in[i];
    a.out = (float*)d_out; a.ws = (unsigned char*)d_ws;
    hipLaunchKernelGGL(mega_fwd, dim3(grid), dim3(NWAVES * 64), LDS_BYTES, stream, a);
}
```
